# Optimizing an MI355X kernel written in HIP

```python
import math
import jax, jax.numpy as jnp
from jax import lax
import numpy as np

D_MODEL = 2048
BATCH = 4
SEQ = 2048
DEPTH = 4

CHUNK = 64
Q_BLOCK = 128
HEAD_DIM = 128
H_MLA = 8
MLA_NOPE = 128
MLA_ROPE = 64
MLA_V = 128
Q_LORA = 512
KV_LORA = 256
ROPE_THETA = 10000.0
H_FOX = 8
H_SB = 8
BRANCH_W = H_MLA * MLA_V
N_BRANCH = 3
DEEPNORM_ALPHA = (2 * DEPTH) ** 0.25
DEEPNORM_BETA = (8 * DEPTH) ** -0.25
LN_EPS = 1e-5
RMS_EPS = 1e-6
NEG_INF = -1e30
SPLIT_SIZES = (Q_LORA, KV_LORA, MLA_ROPE, BRANCH_W,
               3 * BRANCH_W, H_FOX, BRANCH_W,
               3 * BRANCH_W, BRANCH_W,
               N_BRANCH * D_MODEL)
D_IN = sum(SPLIT_SIZES)

kernel_name = 'hybrid_mla_fox_stickbreaking_deepnorm_adaln'


def layer_norm(x, g=None, b=None):
    xf = x.astype(jnp.float32)
    mu = jnp.mean(xf, axis=-1, keepdims=True)
    var = jnp.mean(jnp.square(xf - mu), axis=-1, keepdims=True)
    y = (xf - mu) * lax.rsqrt(var + LN_EPS)
    if g is not None:
        y = y * g.astype(jnp.float32) + b.astype(jnp.float32)
    return y.astype(x.dtype)


def rms_norm(x, g):
    xf = x.astype(jnp.float32)
    y = xf * lax.rsqrt(jnp.mean(xf * xf, axis=-1, keepdims=True) + RMS_EPS)
    return (y * g.astype(jnp.float32)).astype(x.dtype)


def rope(x, positions):
    half = x.shape[-1] // 2
    inv_freq = ROPE_THETA ** (-jnp.arange(half, dtype=jnp.float32) / half)
    ang = positions.astype(jnp.float32)[..., None] * inv_freq
    cos = jnp.cos(ang)[:, :, None, :]
    sin = jnp.sin(ang)[:, :, None, :]
    xf = x.astype(jnp.float32)
    x1, x2 = xf[..., :half], xf[..., half:]
    return jnp.concatenate([x1 * cos - x2 * sin, x2 * cos + x1 * sin], axis=-1).astype(x.dtype)


def split_cols(p, sizes):
    idx, acc = [], 0
    for s in sizes[:-1]:
        acc += s
        idx.append(acc)
    return jnp.split(p, idx, axis=-1)


def sweep_query_blocks(block_fn, q, k, v):
    outs = []
    for i in range(q.shape[1] // Q_BLOCK):
        q0 = i * Q_BLOCK
        q1 = q0 + Q_BLOCK
        outs.append(block_fn(q[:, q0:q1], k[:, :q1], v[:, :q1], q0))
    return jnp.concatenate(outs, axis=1)


def mla_block(q, k, v, q0):
    s = jnp.einsum('bqhd,bkhd->bhqk', q, k).astype(jnp.float32) / math.sqrt(MLA_NOPE + MLA_ROPE)
    t = q0 + jnp.arange(q.shape[1])
    src = jnp.arange(k.shape[1])
    mask = (src[None, :] // CHUNK) <= (t[:, None] // CHUNK)
    p = jax.nn.softmax(jnp.where(mask, s, NEG_INF), axis=-1).astype(v.dtype)
    return jnp.einsum('bhqk,bkhd->bqhd', p, v)


def fox_block(q, k, v, q0, fcum):
    n_q, n_k = q.shape[1], k.shape[1]
    s = jnp.einsum('bqhd,bkhd->bhqk', q, k).astype(jnp.float32) / math.sqrt(HEAD_DIM)
    s = s + fcum[:, :, q0:q0 + n_q, None] - fcum[:, :, None, :n_k]
    t = q0 + jnp.arange(n_q)
    src = jnp.arange(n_k)
    mask = src[None, :] <= t[:, None]
    p = jax.nn.softmax(jnp.where(mask, s, NEG_INF), axis=-1).astype(v.dtype)
    return jnp.einsum('bhqk,bkhd->bqhd', p, v)


def stick_breaking_block(q, k, v, q0):
    z = jnp.einsum('bqhd,bkhd->bhqk', q, k).astype(jnp.float32) / math.sqrt(HEAD_DIM)
    t = q0 + jnp.arange(q.shape[1])
    src = jnp.arange(k.shape[1])
    strict = src[None, :] < t[:, None]
    log_beta = jax.nn.log_sigmoid(z)
    log_1mb = jnp.where(strict, jax.nn.log_sigmoid(-z), 0.0)
    after = lax.cumsum(log_1mb, axis=log_1mb.ndim - 1, reverse=True) - log_1mb
    a = jnp.where(strict, jnp.exp(log_beta + after), 0.0).astype(v.dtype)
    return jnp.einsum('bhqk,bkhd->bqhd', a, v)


def hybrid_layer(x, c, positions, w_ada, b_ada, w_in, q_norm_g, kv_norm_g, w_uq, w_ukv,
                 fox_bias, w_branch, w_out, ln_g, ln_b):
    bsz, seq, _ = x.shape
    mod = c @ w_ada + b_ada
    shift, scale, gate = jnp.split(mod, 3, axis=-1)
    u = layer_norm(x) * (1.0 + scale[:, None, :]) + shift[:, None, :]

    proj = u @ w_in
    (c_q, c_kv, k_rope, g_a, qkv_b, f_logit, g_b, qkv_c, g_c, merge_logit) = split_cols(proj, SPLIT_SIZES)

    q_a = (rms_norm(c_q, q_norm_g) @ w_uq).reshape(bsz, seq, H_MLA, MLA_NOPE + MLA_ROPE)
    q_a = jnp.concatenate([q_a[..., :MLA_NOPE], rope(q_a[..., MLA_NOPE:], positions)], axis=-1)
    kv_a = (rms_norm(c_kv, kv_norm_g) @ w_ukv).reshape(bsz, seq, H_MLA, MLA_NOPE + MLA_V)
    k_pe = jnp.broadcast_to(rope(k_rope[:, :, None, :], positions), (bsz, seq, H_MLA, MLA_ROPE))
    k_a = jnp.concatenate([kv_a[..., :MLA_NOPE], k_pe], axis=-1)
    v_a = kv_a[..., MLA_NOPE:]
    o_a = sweep_query_blocks(mla_block, q_a, k_a, v_a).reshape(bsz, seq, BRANCH_W)

    q_b, k_b, v_b = [t.reshape(bsz, seq, H_FOX, HEAD_DIM) for t in jnp.split(qkv_b, 3, axis=-1)]
    log_f = jax.nn.log_sigmoid(f_logit.astype(jnp.float32) + fox_bias.astype(jnp.float32))
    fcum = jnp.transpose(jnp.cumsum(log_f, axis=1), (0, 2, 1))
    o_b = sweep_query_blocks(lambda qb, kb, vb, q0: fox_block(qb, kb, vb, q0, fcum),
                             q_b, k_b, v_b).reshape(bsz, seq, BRANCH_W)

    q_c, k_c, v_c = [t.reshape(bsz, seq, H_SB, HEAD_DIM) for t in jnp.split(qkv_c, 3, axis=-1)]
    o_c = sweep_query_blocks(stick_breaking_block, q_c, k_c, v_c).reshape(bsz, seq, BRANCH_W)

    ys = jnp.stack([o_a * jax.nn.silu(g_a), o_b * jax.nn.silu(g_b), o_c * jax.nn.silu(g_c)], axis=2)
    branches = jnp.einsum('bsnw,nwd->bsnd', ys, w_branch)
    merge = jax.nn.sigmoid(merge_logit).reshape(bsz, seq, N_BRANCH, D_MODEL)
    merged = jnp.sum(merge * branches, axis=2)
    out = merged @ w_out

    return layer_norm(DEEPNORM_ALPHA * x + gate[:, None, :] * out, ln_g, ln_b)


def setup_inputs(seed: int = 0) -> dict:
    key = jax.random.key(seed)
    ks = jax.random.split(key, 16)
    f32 = jnp.float32
    x = jax.random.normal(ks[0], (BATCH, SEQ, D_MODEL), f32)
    c = jax.random.normal(ks[1], (BATCH, D_MODEL), f32)
    start = jax.random.randint(ks[2], (BATCH, 1), 0, 64, dtype=jnp.int32) * CHUNK
    positions = (start + jnp.arange(SEQ, dtype=jnp.int32)[None, :]).astype(jnp.int32)
    w_ada = jax.random.normal(ks[3], (DEPTH, D_MODEL, 3 * D_MODEL), f32) * (0.5 * D_MODEL ** -0.5)
    b_ada = jax.random.normal(ks[4], (DEPTH, 3 * D_MODEL), f32) * 0.02
    w_in = jax.random.normal(ks[5], (DEPTH, D_MODEL, D_IN), f32) * D_MODEL ** -0.5
    q_norm_g = 1.0 + 0.05 * jax.random.normal(ks[6], (DEPTH, Q_LORA), f32)
    kv_norm_g = 1.0 + 0.05 * jax.random.normal(ks[7], (DEPTH, KV_LORA), f32)
    w_uq = jax.random.normal(ks[8], (DEPTH, Q_LORA, H_MLA * (MLA_NOPE + MLA_ROPE)), f32) * Q_LORA ** -0.5
    w_ukv = jax.random.normal(ks[9], (DEPTH, KV_LORA, H_MLA * (MLA_NOPE + MLA_V)), f32) * KV_LORA ** -0.5
    fox_bias = jax.random.uniform(ks[10], (DEPTH, H_FOX), f32, 1.0, 4.0)
    w_branch = jax.random.normal(ks[11], (DEPTH, N_BRANCH, BRANCH_W, D_MODEL), f32) * (DEEPNORM_BETA * BRANCH_W ** -0.5)
    w_out = jax.random.normal(ks[12], (DEPTH, D_MODEL, D_MODEL), f32) * (DEEPNORM_BETA * D_MODEL ** -0.5)
    ln_g = 1.0 + 0.05 * jax.random.normal(ks[13], (DEPTH, D_MODEL), f32)
    ln_b = 0.02 * jax.random.normal(ks[14], (DEPTH, D_MODEL), f32)
    return {'x': x, 'c': c, 'positions': positions, 'w_ada': w_ada, 'b_ada': b_ada, 'w_in': w_in,
            'q_norm_g': q_norm_g, 'kv_norm_g': kv_norm_g, 'w_uq': w_uq, 'w_ukv': w_ukv,
            'fox_bias': fox_bias, 'w_branch': w_branch, 'w_out': w_out, 'ln_g': ln_g, 'ln_b': ln_b}


def reference(x, c, positions, w_ada, b_ada, w_in, q_norm_g, kv_norm_g, w_uq, w_ukv,
              fox_bias, w_branch, w_out, ln_g, ln_b):
    for l in range(DEPTH):
        x = hybrid_layer(x, c, positions, w_ada[l], b_ada[l], w_in[l], q_norm_g[l], kv_norm_g[l],
                         w_uq[l], w_ukv[l], fox_bias[l], w_branch[l], w_out[l], ln_g[l], ln_b[l])
    return x
```

```cpp
#include <hip/hip_runtime.h>
#include <hip/hip_cooperative_groups.h>
#include <cstdio>
#include <cstdint>
#include <cmath>
namespace cg = cooperative_groups;

#ifndef PER_PHASE_LAUNCH
#define PER_PHASE_LAUNCH 0
#endif

#define LAS __attribute__((address_space(3)))
typedef unsigned short bf16_t;
typedef short bf16x8 __attribute__((ext_vector_type(8)));
typedef float f32x4 __attribute__((ext_vector_type(4)));
typedef float f32x2 __attribute__((ext_vector_type(2)));
typedef float f32x16 __attribute__((ext_vector_type(16)));
typedef unsigned u32x4 __attribute__((ext_vector_type(4)));
typedef unsigned u32x2 __attribute__((ext_vector_type(2)));
typedef __bf16 bf16x2_t __attribute__((ext_vector_type(2)));

constexpr int T = 8192, DM = 2048, SEQ = 2048, NBATCH = 4, NLAYER = 4, DIN = 16200, N1 = 16384;
constexpr float LOG2E = 1.4426950408889634f;
constexpr float ALPHA = 1.681792830507429f;
constexpr int LDS_BYTES = 131072 + 1024;

constexpr size_t al256(size_t x) { return (x + 255) & ~(size_t)255; }
constexpr size_t SZ_BT1 = (size_t)N1 * DM * 2, SZ_BT2Q = (size_t)1536 * 512 * 2, SZ_BT2KV = (size_t)2048 * 256 * 2, SZ_BT3 = (size_t)3 * 2048 * 1024 * 2, SZ_BT4 = (size_t)2048 * 2048 * 2;
constexpr size_t OFF_BT2Q = SZ_BT1, OFF_BT2KV = OFF_BT2Q + SZ_BT2Q, OFF_BT3 = OFF_BT2KV + SZ_BT2KV, OFF_BT4 = OFF_BT3 + SZ_BT3, SZ_WL = OFF_BT4 + SZ_BT4;
constexpr size_t WS_CTR = 0;
constexpr size_t WS_BAR = 256;
constexpr size_t WS_ZERO_BYTES = 256 + 16384;
constexpr size_t WS_W = WS_ZERO_BYTES;
constexpr size_t WS_MOD = al256(WS_W + NLAYER * SZ_WL);
constexpr size_t WS_CS = al256(WS_MOD + (size_t)NLAYER * 4 * 6144 * 4);
constexpr size_t WS_U = al256(WS_CS + (size_t)T * 32 * 8);
constexpr size_t WS_X = al256(WS_U + (size_t)T * DM * 2);
constexpr size_t WS_Y = al256(WS_X + (size_t)T * DM * 4);
constexpr size_t WS_MRG2 = WS_Y;
constexpr size_t WS_CQ = al256(WS_Y + (size_t)T * DM * 4);
constexpr size_t WS_CKV = al256(WS_CQ + (size_t)T * 512 * 2);
constexpr size_t WS_SSQ = al256(WS_CKV + (size_t)T * 256 * 2);
constexpr size_t WS_SG = al256(WS_SSQ + (size_t)T * 16 * 4);
constexpr size_t SZ_TH = (size_t)T * 1024 * 2;
constexpr size_t WS_QB = al256(WS_SG + 3 * SZ_TH), WS_KB = WS_QB + SZ_TH, WS_VBT = WS_KB + SZ_TH, WS_QC = WS_VBT + SZ_TH, WS_KC = WS_QC + SZ_TH, WS_VCT = WS_KC + SZ_TH;
constexpr size_t WS_QAN = WS_VCT + SZ_TH, WS_KAN = WS_QAN + SZ_TH, WS_VAT = WS_KAN + SZ_TH;
constexpr size_t WS_QAR = WS_VAT + SZ_TH;
constexpr size_t WS_KR = al256(WS_QAR + (size_t)T * 512 * 2);
constexpr size_t WS_MISC = al256(WS_KR + (size_t)T * 64 * 2);
constexpr size_t WS_FC = al256(WS_MISC + (size_t)T * 128 * 4);
constexpr size_t WS_MG = al256(WS_FC + (size_t)32 * 2048 * 4);
constexpr size_t WS_YS = al256(WS_MG + (size_t)T * 6144 * 2);
constexpr size_t WS_MACC = al256(WS_YS + 3 * SZ_TH);
constexpr size_t WS_MRG = al256(WS_MACC + (size_t)T * DM * 4);
constexpr size_t WS_END = al256(WS_MRG + (size_t)T * DM * 2);

struct Params {
    const float* x; const float* c; const int* pos; const float* w_ada; const float* b_ada; const float* w_in;
    const float* qng; const float* kvng; const float* w_uq; const float* w_ukv; const float* fox_bias;
    const float* w_branch; const float* w_out; const float* ln_g; const float* ln_b;
    float* out; unsigned char* ws;
    int ph_lo, ph_hi;
};

__device__ __forceinline__ unsigned pk2(float lo, float hi) { f32x2 v = {lo, hi}; bf16x2_t b = __builtin_convertvector(v, bf16x2_t); return __builtin_bit_cast(unsigned, b); }
__device__ __forceinline__ bf16_t f2bf(float x) { return (bf16_t)(pk2(x, 0.f) & 0xffffu); }
__device__ __forceinline__ float bf2f(bf16_t b) { return __uint_as_float(((unsigned)b) << 16); }
__device__ __forceinline__ float wave_sum(float v) {
#pragma unroll
    for (int o = 32; o >= 1; o >>= 1) v += __shfl_xor(v, o);
    return v;
}
__device__ __forceinline__ float sigmoidf_(float x) { return __builtin_amdgcn_rcpf(1.f + __expf(-x)); }
__device__ __forceinline__ float siluf_(float x) { return x * sigmoidf_(x); }
__device__ __forceinline__ float exp2_(float x) { return __builtin_amdgcn_exp2f(x); }
__device__ __forceinline__ float log2_(float x) { return __builtin_amdgcn_logf(x); }
__device__ __forceinline__ float max3_(float a, float b, float c) { float r; asm("v_max3_f32 %0, %1, %2, %3" : "=v"(r) : "v"(a), "v"(b), "v"(c)); return r; }
__device__ __forceinline__ f32x2 pk_sub(f32x2 a, f32x2 b) { f32x2 r; asm("v_pk_add_f32 %0, %1, %2 neg_lo:[0,1] neg_hi:[0,1]" : "=v"(r) : "v"(a), "v"(b)); return r; }
__device__ __forceinline__ f32x2 pk_add(f32x2 a, f32x2 b) { f32x2 r; asm("v_pk_add_f32 %0, %1, %2" : "=v"(r) : "v"(a), "v"(b)); return r; }
__device__ __forceinline__ float swap_max(float x) { auto rr = __builtin_amdgcn_permlane32_swap(__float_as_uint(x), __float_as_uint(x), false, false); return fmaxf(__uint_as_float(rr[0]), __uint_as_float(rr[1])); }
__device__ __forceinline__ float swap_sum(float x) { auto rr = __builtin_amdgcn_permlane32_swap(__float_as_uint(x), __float_as_uint(x), false, false); return __uint_as_float(rr[0]) + __uint_as_float(rr[1]); }
__device__ __forceinline__ float swap_partner(float x, int hh) { auto rr = __builtin_amdgcn_permlane32_swap(__float_as_uint(x), __float_as_uint(x), false, false); return __uint_as_float(hh ? rr[0] : rr[1]); }

__device__ __forceinline__ int my_tid() { int t = threadIdx.x; asm volatile("" : "+v"(t)); return t; }
__device__ __forceinline__ int my_bx() { int b = blockIdx.x; asm volatile("" : "+s"(b)); return b; }
__device__ __forceinline__ int my_G() { int g = gridDim.x; asm volatile("" : "+s"(g)); return g; }
namespace pg8 {
#define PG8_LAS __attribute__((address_space(3)))
constexpr int BM = 256, BK = 64, HALF = 128, HTB = HALF * BK * 2, STAGE_BYTES = 8 * HTB, NXCD = 8, WGM = 8;
__host__ __device__ __forceinline__ int lds_byte(int r, int c) { const int st = (r >> 4) * 2 + (c >> 5), rr = r & 15, cc = c & 31, ob = rr * 64 + cc * 2; return st * 1024 + (ob ^ (((ob >> 9) & 1) << 5)); }
__host__ __device__ __forceinline__ void stage_rc(int b, int& R, int& C) { const int st = b / 1024, sb = b % 1024, swz = sb ^ (((sb >> 9) & 1) << 5); R = (st >> 1) * 16 + swz / 64; C = (st & 1) * 32 + (swz % 64) / 2; }
__host__ __device__ __forceinline__ int perm32(int rho) { const int n = rho >> 4, i = rho & 15; return 8 * (i >> 2) + 4 * n + (i & 3); }
struct Unit { int pm, pn; };
struct Gemm { const bf16_t* A; const bf16_t* Bt; int M, N, K; };
struct StaticOrder {
    int nM, nN, nwg, G, c;
    __host__ __device__ void init(int M, int N, int G_, int c_) { nM = M / BM; nN = N / BM; nwg = nM * nN; G = G_; c = c_; }
    __host__ __device__ bool next(int i, Unit& u) const {
        const long L = (long)i * G + c; if (L >= nwg) return false;
        int wgid = (int)L; { const int q = nwg / NXCD, r = nwg % NXCD, xcd = wgid % NXCD, off = wgid / NXCD; wgid = (xcd < r ? xcd * (q + 1) : r * (q + 1) + (xcd - r) * q) + off; }
        const int nig = WGM * nN, gid = wgid / nig, fm = gid * WGM, gsz = (nM - fm) < WGM ? (nM - fm) : WGM;
        u.pm = fm + ((wgid % nig) % gsz); u.pn = (wgid % nig) / gsz; return true;
    }
    __device__ __forceinline__ void a_ready(const Unit&) const {}
    __device__ __forceinline__ void done(const Unit&) const {}
};
struct BranchOrder {
    StaticOrder so;
    __device__ bool next(int i, Unit& u) const { Unit t; if (!so.next(i / 3, t)) return false; const int n = i % 3; u.pm = n * 32 + t.pm; u.pn = n * 8 + t.pn; return true; }
    __device__ __forceinline__ void a_ready(const Unit&) const {}
    __device__ __forceinline__ void done(const Unit&) const {}
};

template <class Epi, class Sched, bool ALIGN_EPI = false, bool SP2 = false>
__device__ __forceinline__ void gemm_phase(PG8_LAS unsigned char* lds, const Gemm g, const Sched& S, const Epi& E) {
    const int tid = my_tid(), wid = __builtin_amdgcn_readfirstlane(tid >> 6), lane = tid & 63, wr = wid >> 2, wc = wid & 3, fr = lane & 15, fq = lane >> 4;
    const int K = g.K, nt = K / BK;
    unsigned voffA[2], voffB[2];
#pragma unroll
    for (int i = 0; i < 2; ++i) { int R, C; stage_rc(tid * 16 + i * 8192, R, C); const int Rb = Epi::PERM ? ((R & ~31) + perm32(R & 31)) : R;
        voffA[i] = (unsigned)(R * K + C) * 2u; voffB[i] = (unsigned)(Rb * K + C) * 2u; }
    const size_t kstep = (size_t)(BK * 2);
    const size_t hstep = (size_t)HALF * K * 2;
    const size_t tstep = 2 * hstep;
    const unsigned ldsw = (unsigned)wid * 1024u;
    const int aoff = lds_byte(wr * 64 + fr, fq * 8), boff = lds_byte(wc * 32 + fr, fq * 8);
#define PG8_SA(b, h) (((b) * 2 + (h)) * HTB)
#define PG8_SB(b, h) ((4 + (b) * 2 + (h)) * HTB)
#define PG8_STAGE(bufoff, gbase, voff) do { _Pragma("unroll") for (int _i = 0; _i < 2; ++_i) \
        __builtin_amdgcn_global_load_lds((const unsigned*)((const char*)(gbase) + (voff)[_i]), (PG8_LAS unsigned*)(lds + (bufoff) + ldsw + _i * 8192), 16, 0, 0); } while (0)
#define PG8_LDA(dst, b, h) do { _Pragma("unroll") for (int m = 0; m < 4; ++m) _Pragma("unroll") for (int k = 0; k < 2; ++k) dst[m][k] = *(const PG8_LAS bf16x8*)(lds + PG8_SA(b, h) + aoff + m * 2048 + k * 1024); } while (0)
#define PG8_LDB(dst, b, h) do { _Pragma("unroll") for (int n = 0; n < 2; ++n) _Pragma("unroll") for (int k = 0; k < 2; ++k) dst[n][k] = *(const PG8_LAS bf16x8*)(lds + PG8_SB(b, h) + boff + n * 2048 + k * 1024); } while (0)
#define PG8_MMA(ai, bj, At, Bt) do { __builtin_amdgcn_s_setprio(1); _Pragma("unroll") for (int m = 0; m < 4; ++m) _Pragma("unroll") for (int n = 0; n < 2; ++n) _Pragma("unroll") for (int k = 0; k < 2; ++k) \
        acc[ai][bj][m][n] = __builtin_amdgcn_mfma_f32_16x16x32_bf16(Bt[n][k], At[m][k], acc[ai][bj][m][n], 0, 0, 0); __builtin_amdgcn_s_setprio(0); } while (0)
#define PG8_WAIT_V(n) asm volatile("s_waitcnt vmcnt(" #n ")" ::: "memory")
#define PG8_WAIT_L(n) asm volatile("s_waitcnt lgkmcnt(" #n ")" ::: "memory")
#define PG8_BAR __builtin_amdgcn_s_barrier()
#define PG8_SCHED __builtin_amdgcn_sched_barrier(0)
    Unit cur, nxt; int ui = 0;
    if (!S.next(0, cur)) return;
    f32x4 acc[2][2][4][2];
#pragma unroll
    for (int a = 0; a < 2; ++a)
#pragma unroll
        for (int b = 0; b < 2; ++b)
#pragma unroll
            for (int m = 0; m < 4; ++m)
#pragma unroll
                for (int n = 0; n < 2; ++n) acc[a][b][m][n] = (f32x4){0.f, 0.f, 0.f, 0.f};
    bf16x8 At[4][2], B0[2][2], B1[2][2];
    const char* cA = (const char*)g.A + (size_t)cur.pm * tstep; const char* cB = (const char*)g.Bt + (size_t)cur.pn * tstep;
    S.a_ready(cur);
    if constexpr (SP2) {
        PG8_STAGE(PG8_SB(0, 0), cB, voffB); PG8_STAGE(PG8_SB(0, 1), cB + hstep, voffB); PG8_STAGE(PG8_SA(0, 0), cA, voffA); PG8_STAGE(PG8_SA(0, 1), cA + hstep, voffA);
        if (wr == 1) PG8_BAR;
        PG8_WAIT_V(2); PG8_BAR;
        PG8_STAGE(PG8_SB(1, 0), cB + kstep, voffB); PG8_STAGE(PG8_SA(1, 0), cA + kstep, voffA); PG8_STAGE(PG8_SB(1, 1), cB + hstep + kstep, voffB);
        PG8_WAIT_V(6); PG8_BAR;
    } else {
        PG8_STAGE(PG8_SB(0, 0), cB, voffB); PG8_STAGE(PG8_SA(0, 0), cA, voffA); PG8_STAGE(PG8_SB(0, 1), cB + hstep, voffB); PG8_STAGE(PG8_SA(0, 1), cA + hstep, voffA);
        if (wr == 1) PG8_BAR;
        PG8_WAIT_V(4); PG8_BAR;
        PG8_STAGE(PG8_SB(1, 0), cB + kstep, voffB); PG8_STAGE(PG8_SA(1, 0), cA + kstep, voffA); PG8_STAGE(PG8_SB(1, 1), cB + hstep + kstep, voffB);
        PG8_WAIT_V(6); PG8_BAR;
    }
    for (;;) {
        const bool has_next = S.next(ui + 1, nxt);
        const char* nA = has_next ? (const char*)g.A + (size_t)nxt.pm * tstep : cA; const char* nB = has_next ? (const char*)g.Bt + (size_t)nxt.pn * tstep : cB;
#pragma unroll 1
        for (int t = 0; t < nt; t += 2) {
            const bool last = (t == nt - 2);
            const char* a1 = cA + (size_t)(t + 1) * kstep;
            const char* a2 = last ? nA : cA + (size_t)(t + 2) * kstep; const char* b2 = last ? nB : cB + (size_t)(t + 2) * kstep;
            const char* a3 = a2 + kstep; const char* b3 = b2 + kstep;
            if (last && has_next) S.a_ready(nxt);
            if constexpr (SP2) {
            PG8_LDB(B0, 0, 0); PG8_LDB(B1, 0, 1); PG8_SCHED; PG8_LDA(At, 0, 0); PG8_STAGE(PG8_SA(1, 1), a1 + hstep, voffA);
            PG8_WAIT_V(8); PG8_WAIT_L(0); PG8_BAR; PG8_MMA(0, 0, At, B0); PG8_MMA(0, 1, At, B1); PG8_BAR; PG8_SCHED;
            PG8_LDA(At, 0, 1); PG8_STAGE(PG8_SB(0, 0), b2, voffB); PG8_STAGE(PG8_SB(0, 1), b2 + hstep, voffB); PG8_STAGE(PG8_SA(0, 0), a2, voffA);
            PG8_WAIT_V(8); PG8_WAIT_L(0); PG8_BAR; PG8_MMA(1, 0, At, B0); PG8_MMA(1, 1, At, B1); PG8_BAR; PG8_SCHED;
            PG8_LDB(B0, 1, 0); PG8_LDB(B1, 1, 1); PG8_SCHED; PG8_LDA(At, 1, 0); PG8_STAGE(PG8_SA(0, 1), a2 + hstep, voffA);
            PG8_WAIT_V(8); PG8_WAIT_L(0); PG8_BAR; PG8_MMA(0, 0, At, B0); PG8_MMA(0, 1, At, B1); PG8_BAR; PG8_SCHED;
            PG8_LDA(At, 1, 1); PG8_STAGE(PG8_SB(1, 0), b3, voffB); PG8_STAGE(PG8_SB(1, 1), b3 + hstep, voffB); PG8_STAGE(PG8_SA(1, 0), a3, voffA);
            PG8_WAIT_V(8); PG8_WAIT_L(0); PG8_BAR; PG8_MMA(1, 0, At, B0); PG8_MMA(1, 1, At, B1); PG8_BAR; PG8_SCHED;
            } else {
            PG8_LDB(B0, 0, 0); PG8_SCHED; PG8_LDA(At, 0, 0); PG8_STAGE(PG8_SA(1, 1), a1 + hstep, voffA);
            PG8_WAIT_L(8); PG8_BAR; PG8_WAIT_L(0); PG8_MMA(0, 0, At, B0); PG8_BAR; PG8_SCHED;
            PG8_LDB(B1, 0, 1); PG8_STAGE(PG8_SB(0, 0), b2, voffB);
            PG8_BAR; PG8_WAIT_L(0); PG8_MMA(0, 1, At, B1); PG8_BAR;
            PG8_LDA(At, 0, 1); PG8_STAGE(PG8_SA(0, 0), a2, voffA);
            PG8_BAR; PG8_WAIT_L(0); PG8_MMA(1, 0, At, B0); PG8_BAR; PG8_SCHED;
            PG8_STAGE(PG8_SB(0, 1), b2 + hstep, voffB);
            PG8_WAIT_V(6); PG8_BAR; PG8_MMA(1, 1, At, B1); PG8_BAR;
            PG8_LDB(B0, 1, 0); PG8_SCHED; PG8_LDA(At, 1, 0); PG8_STAGE(PG8_SA(0, 1), a2 + hstep, voffA);
            PG8_WAIT_L(8); PG8_BAR; PG8_WAIT_L(0); PG8_MMA(0, 0, At, B0); PG8_BAR; PG8_SCHED;
            PG8_LDB(B1, 1, 1); PG8_STAGE(PG8_SB(1, 0), b3, voffB);
            PG8_BAR; PG8_WAIT_L(0); PG8_MMA(0, 1, At, B1); PG8_BAR;
            PG8_LDA(At, 1, 1); PG8_STAGE(PG8_SA(1, 0), a3, voffA);
            PG8_BAR; PG8_WAIT_L(0); PG8_MMA(1, 0, At, B0); PG8_BAR; PG8_SCHED;
            PG8_STAGE(PG8_SB(1, 1), b3 + hstep, voffB);
            PG8_WAIT_V(6); PG8_BAR; PG8_MMA(1, 1, At, B1); PG8_BAR;
            }
        }
        if constexpr (ALIGN_EPI) { if (wr == 0) PG8_BAR; }
        E(acc, cur, wr, wc, fr, fq); S.done(cur);
        if (!has_next) break;
        if (!E.keep_acc(cur)) {
#pragma unroll
        for (int a = 0; a < 2; ++a)
#pragma unroll
            for (int b = 0; b < 2; ++b)
#pragma unroll
                for (int m = 0; m < 4; ++m)
#pragma unroll
                    for (int n = 0; n < 2; ++n) acc[a][b][m][n] = (f32x4){0.f, 0.f, 0.f, 0.f};
        }
        cur = nxt; cA = nA; cB = nB; ++ui;
        if constexpr (ALIGN_EPI) { if (wr == 1) PG8_BAR; }
    }
    PG8_WAIT_V(0);
    if constexpr (!ALIGN_EPI) { if (wr == 0) PG8_BAR; }
    PG8_BAR;
#undef PG8_SA
#undef PG8_SB
#undef PG8_STAGE
#undef PG8_LDA
#undef PG8_LDB
#undef PG8_MMA
#undef PG8_WAIT_V
#undef PG8_WAIT_L
#undef PG8_BAR
#undef PG8_SCHED
}
}

typedef const f32x4 (&AccRef)[2][2][4][2];
typedef f32x4 (&AccMut)[2][2][4][2];

template <int ACT> __device__ __forceinline__ void store_bf16_tile(AccRef acc, bf16_t* base, int ld, int row0, int cl0) {
#pragma unroll
    for (int ai = 0; ai < 2; ++ai)
#pragma unroll
        for (int m = 0; m < 4; ++m) { bf16_t* rp = base + (size_t)(row0 + ai * 128 + m * 16) * ld + cl0;
#pragma unroll
            for (int bj = 0; bj < 2; ++bj) { f32x4 v0 = acc[ai][bj][m][0], v1 = acc[ai][bj][m][1];
                if (ACT == 1) {
#pragma unroll
                    for (int j = 0; j < 4; ++j) { v0[j] = siluf_(v0[j]); v1[j] = siluf_(v1[j]); } }
                if (ACT == 2) {
#pragma unroll
                    for (int j = 0; j < 4; ++j) { v0[j] = sigmoidf_(v0[j]); v1[j] = sigmoidf_(v1[j]); } }
                u32x4 w; w.x = pk2(v0[0], v0[1]); w.y = pk2(v0[2], v0[3]); w.z = pk2(v1[0], v1[1]); w.w = pk2(v1[2], v1[3]);
                *(u32x4*)(rp + bj * 128) = w; } }
}
__device__ __forceinline__ void store_vt_tile(AccRef acc, bf16_t* VT, int h0, int row0, int cl0, const float* rscale) {
#pragma unroll
    for (int ai = 0; ai < 2; ++ai)
#pragma unroll
        for (int m = 0; m < 4; ++m) { const int row = row0 + ai * 128 + m * 16; const int b = row >> 11, s = row & 2047; const float rs = rscale ? rscale[ai * 4 + m] : 1.f;
#pragma unroll
            for (int bj = 0; bj < 2; ++bj) { const unsigned po = (unsigned)(((b * 8 + h0 + bj) * 128 + cl0) * 2048 + s);
#pragma unroll
                for (int n = 0; n < 2; ++n)
#pragma unroll
                    for (int j = 0; j < 4; ++j) VT[po + (unsigned)((4 * n + j) * 2048)] = f2bf(acc[ai][bj][m][n][j] * rs); }
            asm volatile("" ::: "memory"); }
}

struct Epi1 {
    static constexpr bool PERM = true;
    __device__ __forceinline__ bool keep_acc(const pg8::Unit&) const { return false; }
    unsigned char* ws;
    __device__ __forceinline__ void operator()(AccRef acc, const pg8::Unit& u, int wr, int wc, int fr, int fq) const {
        const int pn = u.pn, row0 = u.pm * 256 + wr * 64 + fr, cl0 = wc * 32 + 8 * fq;
        if (pn < 3) {
            bf16_t* base; int ld, slot;
            if (pn < 2) { base = (bf16_t*)(ws + WS_CQ) + pn * 256; ld = 512; slot = pn * 4 + wc; } else { base = (bf16_t*)(ws + WS_CKV); ld = 256; slot = 8 + wc; }
            float* ssq = (float*)(ws + WS_SSQ);
#pragma unroll
            for (int ai = 0; ai < 2; ++ai)
#pragma unroll
                for (int m = 0; m < 4; ++m) { const int row = row0 + ai * 128 + m * 16; bf16_t* rp = base + (size_t)row * ld + cl0; float ss = 0.f;
#pragma unroll
                    for (int bj = 0; bj < 2; ++bj) { const f32x4 v0 = acc[ai][bj][m][0], v1 = acc[ai][bj][m][1];
                        ss += (v0[0] * v0[0] + v0[1] * v0[1]) + (v0[2] * v0[2] + v0[3] * v0[3]) + (v1[0] * v1[0] + v1[1] * v1[1]) + (v1[2] * v1[2] + v1[3] * v1[3]);
                        u32x4 w; w.x = pk2(v0[0], v0[1]); w.y = pk2(v0[2], v0[3]); w.z = pk2(v1[0], v1[1]); w.w = pk2(v1[2], v1[3]);
                        *(u32x4*)(rp + bj * 128) = w; }
                    ss += __shfl_xor(ss, 16); ss += __shfl_xor(ss, 32);
                    if (fq == 0) ssq[(size_t)row * 16 + slot] = ss; }
        } else if (pn == 63) {
            float* misc = (float*)(ws + WS_MISC);
#pragma unroll
            for (int ai = 0; ai < 2; ++ai)
#pragma unroll
                for (int m = 0; m < 4; ++m) { float* rp = misc + (size_t)(row0 + ai * 128 + m * 16) * 128 + cl0;
                    *(f32x4*)(rp) = acc[ai][0][m][0]; *(f32x4*)(rp + 4) = acc[ai][0][m][1]; }
        } else if (pn >= 39) {
            store_bf16_tile<2>(acc, (bf16_t*)(ws + WS_MG) + (pn - 39) * 256, 6144, row0, cl0);
        } else {
            const int seg = (pn - 3) >> 2, ct = (pn - 3) & 3;
            if (seg == 0 || seg == 4 || seg == 8) store_bf16_tile<1>(acc, (bf16_t*)(ws + WS_SG) + (size_t)(seg >> 2) * T * 1024 + ct * 256, 1024, row0, cl0);
            else if (seg == 3) store_vt_tile(acc, (bf16_t*)(ws + WS_VBT), ct * 2, row0, cl0, nullptr);
            else if (seg == 7) store_vt_tile(acc, (bf16_t*)(ws + WS_VCT), ct * 2, row0, cl0, nullptr);
            else { const size_t off = seg == 1 ? WS_QB : seg == 2 ? WS_KB : seg == 5 ? WS_QC : WS_KC; store_bf16_tile<0>(acc, (bf16_t*)(ws + off) + ct * 256, 1024, row0, cl0); }
        }
    }
};

template <int WHICH  > struct Epi2 {
    static constexpr bool PERM = true;
    __device__ __forceinline__ bool keep_acc(const pg8::Unit&) const { return false; }
    unsigned char* ws;
    __device__ __forceinline__ float rstd(int row) const {
        const float* ssq = (const float*)(ws + WS_SSQ) + (size_t)row * 16 + (WHICH ? 8 : 0);
        const f32x4 a = *(const f32x4*)ssq; float s = (a[0] + a[1]) + (a[2] + a[3]);
        if (WHICH == 0) { const f32x4 b = *(const f32x4*)(ssq + 4); s += (b[0] + b[1]) + (b[2] + b[3]); }
        return rsqrtf(s * (WHICH ? (1.f / 256.f) : (1.f / 512.f)) + 1e-6f);
    }
    __device__ __forceinline__ void operator()(AccRef acc, const pg8::Unit& u, int wr, int wc, int fr, int fq) const {
        const int pn = u.pn, row0 = u.pm * 256 + wr * 64 + fr, cl0 = wc * 32 + 8 * fq;
        if (pn < 4) {
            bf16_t* base = (bf16_t*)(ws + (WHICH ? WS_KAN : WS_QAN)) + pn * 256;
#pragma unroll
            for (int ai = 0; ai < 2; ++ai)
#pragma unroll
                for (int m = 0; m < 4; ++m) { const int row = row0 + ai * 128 + m * 16; bf16_t* rp = base + (size_t)row * 1024 + cl0; const float r = rstd(row);
#pragma unroll
                    for (int bj = 0; bj < 2; ++bj) { const f32x4 v0 = acc[ai][bj][m][0] * r, v1 = acc[ai][bj][m][1] * r;
                        u32x4 w; w.x = pk2(v0[0], v0[1]); w.y = pk2(v0[2], v0[3]); w.z = pk2(v1[0], v1[1]); w.w = pk2(v1[2], v1[3]);
                        *(u32x4*)(rp + bj * 128) = w; }
                    asm volatile("" ::: "memory"); }
        } else if (WHICH == 1) {
            bf16_t* VT = (bf16_t*)(ws + WS_VAT); const int h0 = (pn - 4) * 2;
#pragma unroll
            for (int ai = 0; ai < 2; ++ai)
#pragma unroll
                for (int m = 0; m < 4; ++m) { const int row = row0 + ai * 128 + m * 16; const int b = row >> 11, s = row & 2047; const float rs = rstd(row);
#pragma unroll
                    for (int bj = 0; bj < 2; ++bj) { const unsigned po = (unsigned)(((b * 8 + h0 + bj) * 128 + cl0) * 2048 + s);
#pragma unroll
                        for (int n = 0; n < 2; ++n)
#pragma unroll
                            for (int j = 0; j < 4; ++j) VT[po + (unsigned)((4 * n + j) * 2048)] = f2bf(acc[ai][bj][m][n][j] * rs); }
                    asm volatile("" ::: "memory"); }
        } else {
            bf16_t* base = (bf16_t*)(ws + WS_QAR) + (pn - 4) * 256;
            const f32x2* cs = (const f32x2*)(ws + WS_CS);
#pragma unroll
            for (int ai = 0; ai < 2; ++ai)
#pragma unroll
                for (int m = 0; m < 4; ++m) { const int row = row0 + ai * 128 + m * 16; bf16_t* rp = base + (size_t)row * 512 + cl0; const float r = rstd(row);
#pragma unroll
                    for (int bj = 0; bj < 2; ++bj) { const int j0 = ((bj * 128 + cl0) & 63) >> 1;
                        const f32x4 c01 = *(const f32x4*)(cs + (size_t)row * 32 + j0), c23 = *(const f32x4*)(cs + (size_t)row * 32 + j0 + 2);
                        const f32x4 v0 = acc[ai][bj][m][0] * r, v1 = acc[ai][bj][m][1] * r;
                        u32x4 w;
                        w.x = pk2(v0[0] * c01[0] - v0[1] * c01[1], v0[1] * c01[0] + v0[0] * c01[1]);
                        w.y = pk2(v0[2] * c01[2] - v0[3] * c01[3], v0[3] * c01[2] + v0[2] * c01[3]);
                        w.z = pk2(v1[0] * c23[0] - v1[1] * c23[1], v1[1] * c23[0] + v1[0] * c23[1]);
                        w.w = pk2(v1[2] * c23[2] - v1[3] * c23[3], v1[3] * c23[2] + v1[2] * c23[3]);
                        *(u32x4*)(rp + bj * 128) = w; }
                    asm volatile("" ::: "memory"); }
        }
    }
};

__device__ __forceinline__ void unpack_gate(const u32x4 gw, f32x4& g0, f32x4& g1) {
    g0[0] = __uint_as_float(gw.x << 16); g0[1] = __uint_as_float(gw.x & 0xffff0000u); g0[2] = __uint_as_float(gw.y << 16); g0[3] = __uint_as_float(gw.y & 0xffff0000u);
    g1[0] = __uint_as_float(gw.z << 16); g1[1] = __uint_as_float(gw.z & 0xffff0000u); g1[2] = __uint_as_float(gw.w << 16); g1[3] = __uint_as_float(gw.w & 0xffff0000u);
}
struct Epi3 {
    static constexpr bool PERM = true;
    __device__ __forceinline__ bool keep_acc(const pg8::Unit& u) const { return (u.pm >> 5) < 2; }
    unsigned char* ws;
    __device__ __forceinline__ void operator()(AccMut acc, const pg8::Unit& u, int wr, int wc, int fr, int fq) const {
        const int n = u.pm >> 5, pm = u.pm & 31, pn = u.pn & 7;
        const int row0 = pm * 256 + wr * 64 + fr, col0 = pn * 256 + wc * 32 + 8 * fq;
        const bf16_t* mg = (const bf16_t*)(ws + WS_MG) + n * 2048; bf16_t* mrg = (bf16_t*)(ws + WS_MRG);
#pragma unroll
        for (int ai = 0; ai < 2; ++ai)
#pragma unroll
            for (int m = 0; m < 4; ++m) { const int row = row0 + ai * 128 + m * 16;
#pragma unroll
                for (int bj = 0; bj < 2; ++bj) { const int col = col0 + bj * 128;
                    f32x4 g0, g1; unpack_gate(*(const u32x4*)(mg + (size_t)row * 6144 + col), g0, g1);
#pragma unroll
                    for (int j = 0; j < 4; ++j) { g0[j] = fmaxf(g0[j], 1e-20f); g1[j] = fmaxf(g1[j], 1e-20f); }
                    if (n < 2) { f32x4 h0, h1; unpack_gate(*(const u32x4*)(mg + (size_t)row * 6144 + 2048 + col), h0, h1);
#pragma unroll
                        for (int j = 0; j < 4; ++j) { g0[j] *= __builtin_amdgcn_rcpf(fmaxf(h0[j], 1e-20f)); g1[j] *= __builtin_amdgcn_rcpf(fmaxf(h1[j], 1e-20f)); }
                        acc[ai][bj][m][0] *= g0; acc[ai][bj][m][1] *= g1;
                    } else {
                        const f32x4 v0 = acc[ai][bj][m][0] * g0, v1 = acc[ai][bj][m][1] * g1;
                        u32x4 w; w.x = pk2(v0[0], v0[1]); w.y = pk2(v0[2], v0[3]); w.z = pk2(v1[0], v1[1]); w.w = pk2(v1[2], v1[3]); *(u32x4*)(mrg + (size_t)row * 2048 + col) = w; } } }
    }
};

struct Epi4 {
    static constexpr bool PERM = true;
    __device__ __forceinline__ bool keep_acc(const pg8::Unit&) const { return false; }
    bf16_t* O;
    __device__ __forceinline__ void operator()(AccRef acc, const pg8::Unit& u, int wr, int wc, int fr, int fq) const {
        store_bf16_tile<0>(acc, O + u.pn * 256, 2048, u.pm * 256 + wr * 64 + fr, wc * 32 + 8 * fq);
    }
};

__device__ __forceinline__ int map_bt1(int n, float& sc) {
    sc = 1.f;
    if (n < 768) return n;
    if (n < 1792) return 832 + (n - 768);
    if (n < 2816) { sc = LOG2E * 0.08838834764831845f; return 1856 + (n - 1792); }
    if (n < 3840) return 2880 + (n - 2816);
    if (n < 4864) return 3904 + (n - 3840);
    if (n < 5888) return 4936 + (n - 4864);
    if (n < 6912) { sc = LOG2E * 0.08838834764831845f; return 5960 + (n - 5888); }
    if (n < 7936) return 6984 + (n - 6912);
    if (n < 8960) return 8008 + (n - 7936);
    if (n < 9984) return 9032 + (n - 8960);
    if (n < 16128) return 10056 + (n - 9984);
    const int r = n - 16128;
    if (r < 64) return 768 + 32 * (r & 1) + (r >> 1);
    if (r < 72) return 4928 + (r - 64);
    return -1;
}
constexpr int CT_BT1 = 128 * 16, CT_BT2Q = 12 * 4, CT_BT2KV = 16 * 2, CT_BT3 = 3 * 16 * 8, CT_BT4 = 16 * 16, CT_LAYER = CT_BT1 + CT_BT2Q + CT_BT2KV + CT_BT3 + CT_BT4;
constexpr int NJ_MOD = 192, NJ_CS = 64, NJ_CONV = NLAYER * CT_LAYER, NJ_TOTAL = NJ_MOD + NJ_CS + NJ_CONV;

__device__ __forceinline__ void conv_tile(const Params& P, int job, LAS unsigned char* lds) {
    const int tid = my_tid();
    const int l = job / CT_LAYER; int r = job % CT_LAYER;
    unsigned char* wl = P.ws + WS_W + (size_t)l * SZ_WL;
    int kind, nt, kt; const float* src; int ld; bf16_t* dst; int Kd; const float* gain = nullptr; float gsc = 1.f;
    if (r < CT_BT1) { kind = 0; nt = r >> 4; kt = r & 15; src = P.w_in + (size_t)l * DM * DIN; ld = DIN; dst = (bf16_t*)wl; Kd = 2048; }
    else if ((r -= CT_BT1) < CT_BT2Q) { kind = 1; nt = r >> 2; kt = r & 3; src = P.w_uq + (size_t)l * 512 * 1536; ld = 1536; dst = (bf16_t*)(wl + OFF_BT2Q); Kd = 512; gain = P.qng + l * 512; gsc = LOG2E * 0.07216878364870323f; }
    else if ((r -= CT_BT2Q) < CT_BT2KV) { kind = 2; nt = r >> 1; kt = r & 1; src = P.w_ukv + (size_t)l * 256 * 2048; ld = 2048; dst = (bf16_t*)(wl + OFF_BT2KV); Kd = 256; gain = P.kvng + l * 256; }
    else if ((r -= CT_BT2KV) < CT_BT3) { kind = 3; const int br = r >> 7; r &= 127; nt = r >> 3; kt = r & 7; src = P.w_branch + ((size_t)l * 3 + br) * 1024 * 2048; ld = 2048; dst = (bf16_t*)(wl + OFF_BT3) + (size_t)br * 2048 * 1024; Kd = 1024; }
    else { r -= CT_BT3; kind = 4; nt = r >> 4; kt = r & 15; src = P.w_out + (size_t)l * 2048 * 2048; ld = 2048; dst = (bf16_t*)(wl + OFF_BT4); Kd = 2048; }
    const int nl = tid & 127, kb = tid >> 7, n = nt * 128 + nl;
    int sc_col; float sc = 1.f;
    if (kind == 0) sc_col = map_bt1(n, sc);
    else if (kind == 1) { if (n < 1024) sc_col = (n >> 7) * 192 + (n & 127); else { const int q = n - 1024, h = q >> 6, rr = q & 63; sc_col = h * 192 + 128 + 32 * (rr & 1) + (rr >> 1); } sc = gsc; }
    else if (kind == 2) { if (n < 1024) sc_col = (n >> 7) * 256 + (n & 127); else { const int q = n - 1024; sc_col = (q >> 7) * 256 + 128 + (q & 127); } }
    else sc_col = n;
    LAS bf16_t* tl = (LAS bf16_t*)lds;
    const float* sp = src + (size_t)(kt * 128 + kb) * ld + (sc_col < 0 ? 0 : sc_col);
    float v[32];
#pragma unroll
    for (int i = 0; i < 32; ++i) v[i] = (sc_col >= 0) ? __builtin_nontemporal_load(sp + (size_t)(4 * i) * ld) : 0.f;
#pragma unroll
    for (int i = 0; i < 32; ++i) { float g = sc; if (gain) g *= gain[kt * 128 + kb + 4 * i]; tl[nl * 130 + kb + 4 * i] = f2bf(v[i] * g); }
    __syncthreads();
    const int nr = tid >> 2, kc = tid & 3;
    const LAS unsigned* rp = (const LAS unsigned*)(lds + (nr * 130 + kc * 32) * 2);
    bf16_t* dp = dst + (size_t)(nt * 128 + nr) * Kd + kt * 128 + kc * 32;
#pragma unroll
    for (int q = 0; q < 4; ++q) { u32x4 w; w.x = rp[4 * q]; w.y = rp[4 * q + 1]; w.z = rp[4 * q + 2]; w.w = rp[4 * q + 3]; *(u32x4*)(dp + 8 * q) = w; }
}

__device__ __forceinline__ void mod_job(const Params& P, int job, LAS unsigned char* lds) {
    const int tid = my_tid(), l = job / 48, ct = job % 48;
    LAS float* cl = (LAS float*)lds;
    LAS float* part = (LAS float*)(lds + 32768);
    for (int i = tid; i < 4 * 2048; i += 512) cl[i] = P.c[i];
    __syncthreads();
    const int col = ct * 128 + (tid & 127), kg = tid >> 7;
    const float* wp = P.w_ada + (size_t)l * 2048 * 6144 + (size_t)(kg * 512) * 6144 + col;
    float a0 = 0.f, a1 = 0.f, a2 = 0.f, a3 = 0.f;
    for (int k = 0; k < 512; k += 8) {
        float w[8];
#pragma unroll
        for (int j = 0; j < 8; ++j) w[j] = __builtin_nontemporal_load(wp + (size_t)(k + j) * 6144);
#pragma unroll
        for (int j = 0; j < 8; ++j) { const int kk = kg * 512 + k + j; a0 += cl[kk] * w[j]; a1 += cl[2048 + kk] * w[j]; a2 += cl[4096 + kk] * w[j]; a3 += cl[6144 + kk] * w[j]; }
    }
    part[(kg * 4 + 0) * 128 + (tid & 127)] = a0; part[(kg * 4 + 1) * 128 + (tid & 127)] = a1; part[(kg * 4 + 2) * 128 + (tid & 127)] = a2; part[(kg * 4 + 3) * 128 + (tid & 127)] = a3;
    __syncthreads();
    { const int b = tid >> 7, c = tid & 127; const float s = part[(0 * 4 + b) * 128 + c] + part[(1 * 4 + b) * 128 + c] + part[(2 * 4 + b) * 128 + c] + part[(3 * 4 + b) * 128 + c];
      ((float*)(P.ws + WS_MOD))[((size_t)l * 4 + b) * 6144 + ct * 128 + c] = s + P.b_ada[(size_t)l * 6144 + ct * 128 + c]; }
}

__device__ __forceinline__ void cs_job(const Params& P, int job) {
    f32x2* cs = (f32x2*)(P.ws + WS_CS);
    const int tid = my_tid();
#pragma unroll
    for (int i = 0; i < 8; ++i) { const int idx = job * 4096 + i * 512 + tid; const int tok = idx >> 5, j = idx & 31;
        double pw = 1.0, bs = 0.749894209332456; { if (j & 1) pw *= bs; bs *= bs; if (j & 2) pw *= bs; bs *= bs; if (j & 4) pw *= bs; bs *= bs; if (j & 8) pw *= bs; bs *= bs; if (j & 16) pw *= bs; }
        const float ang = (float)P.pos[tok] * (float)pw;
        double rev = (double)ang * 0.15915494309189535; rev -= __builtin_rint(rev);
        const float rf = (float)rev;
        cs[idx] = (f32x2){__builtin_amdgcn_cosf(rf), __builtin_amdgcn_sinf(rf)}; }
}

__device__ __forceinline__ void phase_prologue(const Params& P, LAS unsigned char* lds, int ci) {
    const int G = my_G(), c = my_bx();
    if (G == 256) {
        static_assert(NJ_MOD == 192 && NJ_CS == 64 && NJ_CONV == 41 * 256 + 9 * 64, "static prologue deal");
        if (c < NJ_MOD) mod_job(P, c, lds); else cs_job(P, c - NJ_MOD);
#pragma unroll 1
        for (int r = 0; r < 41; ++r) { __syncthreads(); conv_tile(P, r * 256 + c, lds); }
        if (c >= NJ_MOD) {
#pragma unroll 1
            for (int j = 0; j < 9; ++j) { __syncthreads(); conv_tile(P, 41 * 256 + (c - NJ_MOD) + 64 * j, lds); }
        }
        __syncthreads();
        return;
    }
    unsigned* ctr = (unsigned*)(P.ws + WS_CTR) + ci * 16;
    LAS int* slot = (LAS int*)(lds + 131072);
    const int tid0 = my_tid();
    for (;;) {
        __syncthreads();
        if (tid0 == 0) *slot = (int)atomicAdd(ctr, 1u);
        __syncthreads();
        const int job = *slot;
        if (job >= NJ_TOTAL) break;
        if (job < NJ_MOD) mod_job(P, job, lds);
        else if (job < NJ_MOD + NJ_CS) cs_job(P, job - NJ_MOD);
        else conv_tile(P, job - NJ_MOD - NJ_CS, lds);
    }
}

__device__ __forceinline__ void row_stats(const f32x4 (&v)[8], float& mean, float& rstd) {
    float s = 0.f;
#pragma unroll
    for (int i = 0; i < 8; ++i) s += (v[i][0] + v[i][1]) + (v[i][2] + v[i][3]);
    mean = wave_sum(s) * (1.f / 2048.f);
    float q = 0.f;
#pragma unroll
    for (int i = 0; i < 8; ++i) { const f32x4 d = v[i] - mean; q += (d[0] * d[0] + d[1] * d[1]) + (d[2] * d[2] + d[3] * d[3]); }
    rstd = rsqrtf(wave_sum(q) * (1.f / 2048.f) + 1e-5f);
}
__device__ __forceinline__ void phase_ln(const Params& P, int l) {
    const int tid = my_tid(), bx = my_bx(), G = my_G();
    const int wid = tid >> 6, lane = tid & 63;
    float* X = (float*)(P.ws + WS_X); bf16_t* U = (bf16_t*)(P.ws + WS_U);
    const float* xsrc = (l <= 1) ? P.x : X;
    const bf16_t* outb = (const bf16_t*)(P.ws + WS_MRG2);
    const float* g = P.ln_g + (size_t)(l > 0 ? l - 1 : 0) * 2048; const float* bb = P.ln_b + (size_t)(l > 0 ? l - 1 : 0) * 2048;
    const float* mod = (const float*)(P.ws + WS_MOD) + (size_t)(l < 4 ? l : 0) * 4 * 6144;
    const float* gate = (const float*)(P.ws + WS_MOD) + (size_t)(l > 0 ? l - 1 : 0) * 4 * 6144 + 4096;
    for (int row = bx * 8 + wid; row < T; row += G * 8) {
        f32x4 v[8];
#pragma unroll
        for (int i = 0; i < 8; ++i) v[i] = __builtin_nontemporal_load((const f32x4*)(xsrc + (size_t)row * 2048 + (i * 64 + lane) * 4));
        if (l >= 1) {
            const float* gp = gate + (size_t)(row >> 11) * 6144;
#pragma unroll
            for (int i = 0; i < 8; ++i) { const int col = (i * 64 + lane) * 4; const u32x2 ow = __builtin_nontemporal_load((const u32x2*)(outb + (size_t)row * 2048 + col)); const f32x4 gv = *(const f32x4*)(gp + col);
                f32x4 o; o[0] = __uint_as_float(ow.x << 16); o[1] = __uint_as_float(ow.x & 0xffff0000u); o[2] = __uint_as_float(ow.y << 16); o[3] = __uint_as_float(ow.y & 0xffff0000u);
                v[i] = v[i] * ALPHA + gv * o; }
        }
        float mean, rstd; row_stats(v, mean, rstd);
        if (l >= 1) {
            float* dst = (l == 4) ? P.out : X;
#pragma unroll
            for (int i = 0; i < 8; ++i) { const int col = (i * 64 + lane) * 4; const f32x4 gv = *(const f32x4*)(g + col), bv = *(const f32x4*)(bb + col);
                v[i] = (v[i] - mean) * rstd * gv + bv; *(f32x4*)(dst + (size_t)row * 2048 + col) = v[i]; }
            if (l == 4) continue;
            row_stats(v, mean, rstd);
        }
        const float* mp = mod + (size_t)(row >> 11) * 6144;
#pragma unroll
        for (int i = 0; i < 8; ++i) { const int col = (i * 64 + lane) * 4; const f32x4 sh = *(const f32x4*)(mp + col), sc = *(const f32x4*)(mp + 2048 + col);
            const f32x4 uu = (v[i] - mean) * rstd * (sc + 1.f) + sh; u32x2 w; w.x = pk2(uu[0], uu[1]); w.y = pk2(uu[2], uu[3]);
            *(u32x2*)(U + (size_t)row * 2048 + col) = w; }
    }
}

__device__ __forceinline__ void phase_small(const Params& P, int l) {
    const float* misc = (const float*)(P.ws + WS_MISC); const f32x2* cs = (const f32x2*)(P.ws + WS_CS); bf16_t* kr = (bf16_t*)(P.ws + WS_KR);
    const int tid = my_tid(), bx = my_bx(), G = my_G();
    for (int idx = bx * 512 + tid; idx < T * 32; idx += G * 512) { const int tok = idx >> 5, j = idx & 31;
        const f32x2 x = *(const f32x2*)(misc + (size_t)tok * 128 + 2 * j); const f32x2 c = cs[idx];
        *(unsigned*)(kr + (size_t)tok * 64 + 2 * j) = pk2(x[0] * c[0] - x[1] * c[1], x[1] * c[0] + x[0] * c[1]); }
    const int wid = tid >> 6, lane = tid & 63;
    const int fb0 = (G >= 200) ? 192 : 0;
    for (int sid = (bx - fb0) * 8 + wid; sid < 32 && bx >= fb0; sid += G * 8) { const int b = sid >> 3, h = sid & 7; const float bias = P.fox_bias[l * 8 + h];
        float loc[32]; float run = 0.f;
#pragma unroll
        for (int i = 0; i < 32; ++i) { const int s = lane * 32 + i; const float xx = misc[(size_t)(b * 2048 + s) * 128 + 64 + h] + bias;
            const float ls = -(fmaxf(-xx, 0.f) + log1pf(expf(-fabsf(xx)))); run += ls; loc[i] = run; }
        float incl = run;
#pragma unroll
        for (int o = 1; o < 64; o <<= 1) { const float t = __shfl_up(incl, o); if (lane >= o) incl += t; }
        const float excl = incl - run; float* fc = (float*)(P.ws + WS_FC) + (size_t)sid * 2048 + lane * 32;
#pragma unroll
        for (int i = 0; i < 32; ++i) fc[i] = (loc[i] + excl) * LOG2E; }
}

#define MFMA32(a, b, c) __builtin_amdgcn_mfma_f32_32x32x16_bf16((a), (b), (c), 0, 0, 0)
__device__ __forceinline__ bf16x8 pack8(const f32x16& x, int s) {
    u32x4 p;
    if (s == 0) { p.x = pk2(x[0], x[1]); p.y = pk2(x[2], x[3]); p.z = pk2(x[4], x[5]); p.w = pk2(x[6], x[7]); }
    else { p.x = pk2(x[8], x[9]); p.y = pk2(x[10], x[11]); p.z = pk2(x[12], x[13]); p.w = pk2(x[14], x[15]); }
    return __builtin_bit_cast(bf16x8, p);
}
__device__ __forceinline__ float exp2_negabs(float x) { float r; asm("v_exp_f32 %0, -|%1|\n\ts_nop 1" : "=v"(r) : "v"(x)); return r; }
__device__ __forceinline__ void sb_sub(f32x16& s, float& carry, const int hh) {
    float w[16];
#pragma unroll
    for (int i = 0; i < 16; ++i) { const float z = s[i]; const float t = log2_(1.f + exp2_negabs(z));
        w[i] = -(__builtin_fmaxf(z, 0.f) + t); }
    const float GA = ((w[0] + w[1]) + (w[2] + w[3])) + ((w[4] + w[5]) + (w[6] + w[7])), GB = ((w[8] + w[9]) + (w[10] + w[11])) + ((w[12] + w[13]) + (w[14] + w[15]));
    const float GAp = swap_partner(GA, hh), GBp = swap_partner(GB, hh);
    float a = carry + (hh == 0 ? GBp : 0.f);
#pragma unroll
    for (int i = 15; i >= 8; --i) { const float wi = w[i]; s[i] = exp2_((s[i] + wi) + a); a += wi; }
    a = carry + GB + GBp + (hh == 0 ? GAp : 0.f);
#pragma unroll
    for (int i = 7; i >= 0; --i) { const float wi = w[i]; s[i] = exp2_((s[i] + wi) + a); a += wi; }
    carry += (GA + GB) + (GAp + GBp);
}

template <int N> __device__ __forceinline__ void at_waitv() {
    if constexpr (N == 0) asm volatile("s_waitcnt vmcnt(0)" ::: "memory");
    else if constexpr (N == 2) asm volatile("s_waitcnt vmcnt(2)" ::: "memory");
    else if constexpr (N == 3) asm volatile("s_waitcnt vmcnt(3)" ::: "memory");
    else if constexpr (N == 4) asm volatile("s_waitcnt vmcnt(4)" ::: "memory");
    else if constexpr (N == 5) asm volatile("s_waitcnt vmcnt(5)" ::: "memory");
    else static_assert(N == 0, "at_waitv: add the count");
}
#define AT_BAR() do { asm volatile("" ::: "memory"); __builtin_amdgcn_s_barrier(); asm volatile("" ::: "memory"); } while (0)
template <int TYPE  >
__device__ __forceinline__ void attn_item(const Params& P, const int b, const int h, const int qt, LAS unsigned char* lds) {
    constexpr int DQK = TYPE == 0 ? 192 : 128, KS = DQK / 16, KROWB = DQK * 2, KREG = 64 * KROWB, VREG = 16384, FREG = TYPE == 1 ? 2048 : 0, SLOT = KREG + VREG + FREG;
    constexpr int NKI = KREG / 8192, NI = NKI + 2 + (TYPE == 1 ? 1 : 0), FLAGS = 126976;
    static_assert(3 * SLOT <= FLAGS && SLOT % 256 == 0, "ring");
    const int tid = my_tid(), wid = __builtin_amdgcn_readfirstlane(tid >> 6), lane = tid & 63, l32 = lane & 31, hh = lane >> 5;
    unsigned char* ws = P.ws;
    const int bh = b * 8 + h;
    const int tq = qt * 256 + wid * 32 + l32;
    const size_t tokq = (size_t)b * 2048 + tq;
    const int NT = 4 * qt + 4, wlast = 4 * qt + (wid >> 1);
    const char* kptr[NKI]; unsigned kstr[NKI]; const char* vptr[2];
    const char* Kbase = (const char*)(ws + (TYPE == 0 ? WS_KAN : TYPE == 1 ? WS_KB : WS_KC));
#pragma unroll
    for (int i = 0; i < NKI; ++i) { const int p = (wid * NKI + i) * 64 + lane;
        if (TYPE == 0) { const int rho = p / 24, cp = p - rho * 24, c = (cp & ~7) | ((cp & 7) ^ ((rho >> 1) & 7));
            if (c < 16) { kptr[i] = Kbase + ((size_t)(b * 2048 + rho) * 1024 + h * 128) * 2 + c * 16; kstr[i] = 131072u; }
            else { kptr[i] = (const char*)(ws + WS_KR) + (size_t)(b * 2048 + rho) * 128 + (c - 16) * 16; kstr[i] = 8192u; }
        } else { const int rho = p >> 4, c = (p & 15) ^ (rho & 15); kptr[i] = Kbase + ((size_t)(b * 2048 + rho) * 1024 + h * 128) * 2 + c * 16; kstr[i] = 131072u; } }
    const char* Vbase = (const char*)(ws + (TYPE == 0 ? WS_VAT : TYPE == 1 ? WS_VBT : WS_VCT));
#pragma unroll
    for (int i = 0; i < 2; ++i) { const int p = (wid * 2 + i) * 64 + lane, r = p >> 3, c = (p & 7) ^ ((r >> 1) & 7); vptr[i] = Vbase + ((size_t)(bh * 128 + r) * 2048) * 2 + c * 16; }
    const char* fptr = (const char*)(ws + WS_FC) + ((size_t)bh * 2048 + lane) * 4;
#define AT_ISSUE(kt, so) do { \
        _Pragma("unroll") for (int i_ = 0; i_ < NKI; ++i_) __builtin_amdgcn_global_load_lds((const unsigned*)(kptr[i_] + (size_t)(kt) * kstr[i_]), (LAS unsigned*)(lds + (so) + (wid * NKI + i_) * 1024), 16, 0, 0); \
        _Pragma("unroll") for (int i_ = 0; i_ < 2; ++i_) __builtin_amdgcn_global_load_lds((const unsigned*)(vptr[i_] + (size_t)(kt) * 128), (LAS unsigned*)(lds + (so) + KREG + (wid * 2 + i_) * 1024), 16, 0, 0); \
        if (TYPE == 1) __builtin_amdgcn_global_load_lds((const unsigned*)(fptr + (size_t)(kt) * 256), (LAS unsigned*)(lds + (so) + KREG + VREG + wid * 256), 4, 0, 0); } while (0)
#define AT_TILE(it_) (TYPE == 2 ? NT - 1 - (it_) : (it_))
    float m_run = -1e30f, l_run = 0.f, carry = 0.f;
    f32x16 o0, o1, o2, o3;
#pragma unroll
    for (int i = 0; i < 16; ++i) { o0[i] = 0.f; o1[i] = 0.f; o2[i] = 0.f; o3[i] = 0.f; }
    const int pl = (l32 & ~12) | ((l32 & 4) << 1) | ((l32 & 8) >> 1);
    const unsigned a0k = (unsigned)(pl * KROWB + ((((TYPE == 0) ? ((pl >> 1) & 7) : (pl & 15)) ^ hh) << 4));
    const unsigned a0v = (unsigned)(KREG + l32 * 128 + ((((l32 >> 1) & 7) ^ hh) << 4));
    const bool ahead = false; bool have_s = false; bool wv_done = false;
    f32x16 s0, s1;
#define AT_KADDR(ks) ((TYPE == 0) ? ((kb_ ^ (unsigned)(32 * ((ks) & 3))) + (unsigned)(((ks) >> 2) * 128)) : (kb_ ^ (unsigned)(32 * (ks))))
#define AT_RK(c) do { _Pragma("unroll") for (int ks = CH * (c); ks < CH * (c) + CH; ++ks) { const unsigned ka = AT_KADDR(ks); kfa[ks] = *(const LAS bf16x8*)(lds + ka); kfb[ks] = *(const LAS bf16x8*)(lds + ka + 32 * KROWB); } } while (0)
#define AT_MK(c) do { _Pragma("unroll") for (int ks = CH * (c); ks < CH * (c) + CH; ++ks) { s0 = MFMA32(kfa[ks], qf[ks], s0); s1 = MFMA32(kfb[ks], qf[ks], s1); } } while (0)
    constexpr int CH = (KS == 12) ? 3 : 4, NC = KS / CH;
#define AT_QK(so_) do { \
        _Pragma("unroll") for (int i_ = 0; i_ < 16; ++i_) { s0[i_] = 0.f; s1[i_] = 0.f; } \
        const unsigned kb_ = a0k + (so_); bf16x8 kfa[KS], kfb[KS]; \
        AT_RK(0); \
        _Pragma("unroll") for (int c_ = 0; c_ < NC; ++c_) { if (c_ + 1 < NC) { AT_RK(c_ + 1); } __builtin_amdgcn_sched_barrier(0); AT_MK(c_); __builtin_amdgcn_sched_barrier(0); } \
          \
        asm volatile("s_nop 7\n\ts_nop 7\n\ts_nop 3" : "+v"(s0), "+v"(s1)); } while (0)
    at_waitv<0>(); AT_BAR();
    AT_ISSUE(AT_TILE(0), 0); AT_ISSUE(AT_TILE(1), SLOT);
    bf16x8 qf[KS];
    if (TYPE == 0) {
        const bf16_t* qn = (const bf16_t*)(ws + WS_QAN) + tokq * 1024 + h * 128 + hh * 8; const bf16_t* qr = (const bf16_t*)(ws + WS_QAR) + tokq * 512 + h * 64 + hh * 8;
#pragma unroll
        for (int ks = 0; ks < 8; ++ks) qf[ks] = *(const bf16x8*)(qn + ks * 16);
#pragma unroll
        for (int ks = 8; ks < KS; ++ks) qf[ks] = *(const bf16x8*)(qr + (ks - 8) * 16);
    } else {
        const bf16_t* qp = (const bf16_t*)(ws + (TYPE == 1 ? WS_QB : WS_QC)) + tokq * 1024 + h * 128 + hh * 8;
#pragma unroll
        for (int ks = 0; ks < KS; ++ks) qf[ks] = *(const bf16x8*)(qp + ks * 16);
    }
#pragma unroll
    for (int ks = 0; ks < KS; ++ks) asm volatile("" : "+v"(qf[ks]));
    unsigned so = 0, so2 = 2 * SLOT;
    for (int it = 0; it < NT; ++it) {
        const int kt = AT_TILE(it);
        if (it + 1 < NT) at_waitv<NI>(); else at_waitv<0>();
        AT_BAR();
        if (TYPE == 2 && it > 0) { const LAS int* fl = (const LAS int*)(lds + FLAGS + ((it - 1) & 1) * 32);
            if (fl[0] & fl[1] & fl[2] & fl[3] & fl[4] & fl[5] & fl[6] & fl[7]) break; }
        if (it + 2 < NT) AT_ISSUE(AT_TILE(it + 2), so2);
        if (kt <= wlast && !(TYPE == 2 && wv_done)) {
            if (!have_s) { AT_QK(so); }
            const unsigned vb = a0v + so;
            bf16x8 vf0[4], vf1[4], vf2[4], vf3[4];
#define AT_RV(vf, mb) do { vf[0] = *(const LAS bf16x8*)(lds + vb + (mb) * 4096); vf[1] = *(const LAS bf16x8*)(lds + (vb ^ 32u) + (mb) * 4096); \
                vf[2] = *(const LAS bf16x8*)(lds + (vb ^ 64u) + (mb) * 4096); vf[3] = *(const LAS bf16x8*)(lds + (vb ^ 96u) + (mb) * 4096); } while (0)
            AT_RV(vf0, 0);
            __builtin_amdgcn_sched_barrier(0);
            const bool diag = (kt == wlast);
            const int key0 = kt * 64 + 8 * hh;
            if (TYPE == 2) {
                if (diag) {
#pragma unroll
                    for (int i = 0; i < 16; ++i) { const int key = key0 + 16 * (i >> 3) + (i & 7); if (key >= tq) s0[i] = -1e30f; if (key + 32 >= tq) s1[i] = -1e30f; } }
                sb_sub(s1, carry, hh); sb_sub(s0, carry, hh);
            } else {
                if (TYPE == 1) { const LAS float* fb = (const LAS float*)(lds + so + KREG + VREG + wid * 256) + 8 * hh;
#pragma unroll
                    for (int j = 0; j < 8; ++j) {
                        const f32x2 b0 = *(const LAS f32x2*)(fb + 16 * (j >> 2) + 2 * (j & 3)), b1 = *(const LAS f32x2*)(fb + 32 + 16 * (j >> 2) + 2 * (j & 3));
                        const f32x2 x0 = pk_sub((f32x2){s0[2 * j], s0[2 * j + 1]}, b0), x1 = pk_sub((f32x2){s1[2 * j], s1[2 * j + 1]}, b1);
                        s0[2 * j] = x0[0]; s0[2 * j + 1] = x0[1]; s1[2 * j] = x1[0]; s1[2 * j + 1] = x1[1]; }
                    if (diag) {
#pragma unroll
                        for (int i = 0; i < 16; ++i) { const int key = key0 + 16 * (i >> 3) + (i & 7); if (key > tq) s0[i] = -1e30f; if (key + 32 > tq) s1[i] = -1e30f; } } }
                float mx = m_run;
#pragma unroll
                for (int i = 0; i < 16; ++i) mx = max3_(mx, s0[i], s1[i]);
                asm volatile("s_nop 1" : "+v"(mx));
                const float mnew = swap_max(mx);
                const f32x2 mm = {mnew, mnew}; f32x2 rs2 = {0.f, 0.f};
#pragma unroll
                for (int j = 0; j < 8; ++j) { const f32x2 x0 = pk_sub((f32x2){s0[2 * j], s0[2 * j + 1]}, mm), x1 = pk_sub((f32x2){s1[2 * j], s1[2 * j + 1]}, mm);
                    s0[2 * j] = exp2_(x0[0]); s0[2 * j + 1] = exp2_(x0[1]); s1[2 * j] = exp2_(x1[0]); s1[2 * j + 1] = exp2_(x1[1]);
                    rs2 += (f32x2){s0[2 * j], s0[2 * j + 1]} + (f32x2){s1[2 * j], s1[2 * j + 1]}; }
                const float rs = rs2[0] + rs2[1];
                if (__any(mnew > m_run)) {
                    const float alpha = exp2_(m_run - mnew);
                    l_run *= alpha; o0 *= alpha; o1 *= alpha; o2 *= alpha; o3 *= alpha;
                }
                l_run += rs; m_run = mnew;
            }
            const bf16x8 p00 = pack8(s0, 0), p01 = pack8(s0, 1), p10 = pack8(s1, 0), p11 = pack8(s1, 1);
#define AT_PV(o, vf) do { o = MFMA32(vf[0], p00, o); o = MFMA32(vf[1], p01, o); o = MFMA32(vf[2], p10, o); o = MFMA32(vf[3], p11, o); } while (0)
            __builtin_amdgcn_sched_barrier(0);
            AT_RV(vf1, 1); AT_PV(o0, vf0); __builtin_amdgcn_sched_barrier(0);
            AT_RV(vf2, 2); AT_PV(o1, vf1); __builtin_amdgcn_sched_barrier(0);
            AT_RV(vf3, 3); AT_PV(o2, vf2); __builtin_amdgcn_sched_barrier(0);
            AT_PV(o3, vf3); __builtin_amdgcn_sched_barrier(0);
#undef AT_PV
#undef AT_RV
        }
        if (TYPE == 2) { wv_done = wv_done || ((kt <= wlast) && __all(carry < -140.f)); if (lane == 0) *(LAS int*)(lds + FLAGS + (it & 1) * 32 + wid * 4) = wv_done ? 1 : 0; }
        so = (so == 2 * SLOT) ? 0u : so + SLOT; so2 = (so2 == 2 * SLOT) ? 0u : so2 + SLOT;
        have_s = false;
        if (ahead && it + 1 < NT && AT_TILE(it + 1) <= wlast) { AT_QK(so); have_s = true; }
    }
#undef AT_ISSUE
#undef AT_TILE
#undef AT_QK
#undef AT_RK
#undef AT_MK
#undef AT_KADDR
    float inv = 1.f;
    if (TYPE != 2) inv = 1.f / swap_sum(l_run);
    at_waitv<0>(); AT_BAR();
    {
        const unsigned ob = (unsigned)(wid * 8704 + l32 * 272 + 8 * hh);
#define AT_OUT(o, mb) do { _Pragma("unroll") for (int g = 0; g < 4; ++g) { u32x2 w; w.x = pk2(o[4 * g] * inv, o[4 * g + 1] * inv); w.y = pk2(o[4 * g + 2] * inv, o[4 * g + 3] * inv); \
            *(LAS u32x2*)(lds + ob + (mb) * 64 + g * 16) = w; } } while (0)
        AT_OUT(o0, 0); AT_OUT(o1, 1); AT_OUT(o2, 2); AT_OUT(o3, 3);
#undef AT_OUT
        const size_t tok0 = (size_t)b * 2048 + qt * 256 + wid * 32;
        const bf16_t* sg = (const bf16_t*)(ws + WS_SG) + (size_t)TYPE * T * 1024 + tok0 * 1024 + h * 128;
        bf16_t* ys = (bf16_t*)(ws + WS_YS) + (size_t)TYPE * T * 1024 + tok0 * 1024 + h * 128;
        u32x4 gv[8];
#pragma unroll
        for (int i = 0; i < 8; ++i) { const int c = lane + 64 * i, r = c >> 4, cc = c & 15; gv[i] = *(const u32x4*)(sg + (size_t)r * 1024 + cc * 8); }
#pragma unroll
        for (int i = 0; i < 8; ++i) { const int c = lane + 64 * i, r = c >> 4, cc = c & 15;
            const u32x4 ov = *(const LAS u32x4*)(lds + wid * 8704 + r * 272 + cc * 16); u32x4 w;
            w.x = pk2(__uint_as_float(ov.x << 16) * __uint_as_float(gv[i].x << 16), __uint_as_float(ov.x & 0xffff0000u) * __uint_as_float(gv[i].x & 0xffff0000u));
            w.y = pk2(__uint_as_float(ov.y << 16) * __uint_as_float(gv[i].y << 16), __uint_as_float(ov.y & 0xffff0000u) * __uint_as_float(gv[i].y & 0xffff0000u));
            w.z = pk2(__uint_as_float(ov.z << 16) * __uint_as_float(gv[i].z << 16), __uint_as_float(ov.z & 0xffff0000u) * __uint_as_float(gv[i].z & 0xffff0000u));
            w.w = pk2(__uint_as_float(ov.w << 16) * __uint_as_float(gv[i].w << 16), __uint_as_float(ov.w & 0xffff0000u) * __uint_as_float(gv[i].w & 0xffff0000u));
            *(u32x4*)(ys + (size_t)r * 1024 + cc * 8) = w; }
    }
}

__device__ __forceinline__ void attn_run(const Params& P, int type, int bh, int qt, LAS unsigned char* lds) {
    const int b = bh >> 3, h = bh & 7;
#ifndef ATT_MASK
#define ATT_MASK 7
#endif
    if ((ATT_MASK & 1) && type == 0) attn_item<0>(P, b, h, qt, lds); else if ((ATT_MASK & 2) && type == 1) attn_item<1>(P, b, h, qt, lds); else if ((ATT_MASK & 4) && type == 2) attn_item<2>(P, b, h, qt, lds);
}
__device__ __forceinline__ void phase_attn(const Params& P, LAS unsigned char* lds) {
    const int G = my_G(), c = my_bx();
    if (G == 256) {
        const int x = c & 7, j = c >> 3, bh = 4 * x + (j >> 3), k = j & 7;
#pragma unroll 1
        for (int r = 0; r < 3; ++r) attn_run(P, r, bh, r == 0 ? k : 7 - k, lds);
    } else {
#pragma unroll 1
        for (int idx = c; idx < 768; idx += G) { const int qt = 7 - idx / 96, r = idx % 96; attn_run(P, r >> 5, r & 31, qt, lds); }
    }
    asm volatile("s_waitcnt vmcnt(0)" ::: "memory"); __syncthreads();
}

#define XB_TMO      128
#define XB_XCNT(j)  (256  + 64 * (j))
#define XB_XSUB(j)  (1280 + 64 * (j))
#define XB_XGEN(j)  (2304 + 64 * (j))
#define XB_TOP      3328
#define XB_TOPGEN   3392
#define XCD_BAR_WORDS 3456
#define XB_SPIN_CAP (1u << 18)
__device__ __forceinline__ unsigned xb_ld(unsigned* p)              { return __hip_atomic_load(p, __ATOMIC_RELAXED, __HIP_MEMORY_SCOPE_AGENT); }
__device__ __forceinline__ unsigned xb_add(unsigned* p, unsigned v) { return __hip_atomic_fetch_add(p, v, __ATOMIC_RELAXED, __HIP_MEMORY_SCOPE_AGENT); }
__device__ __forceinline__ unsigned xb_xcc_id() { return (unsigned)__builtin_amdgcn_s_getreg((3 << 11) | 20) & 0xFu; }
#define XB_SPIN(cond, bar) do { unsigned _sp = 0; while (cond) { __builtin_amdgcn_s_sleep(1); \
    if ((++_sp & 255u) == 0u) { if (xb_ld(&(bar)[XB_TMO])) break; if (_sp > XB_SPIN_CAP) { atomicAdd(&(bar)[XB_TMO], 1u); break; } } } } while (0)
struct XcdBarrier { unsigned* bar; unsigned x; volatile LAS unsigned* st; };
__device__ __forceinline__ XcdBarrier xcd_barrier_post(unsigned* bar, volatile LAS unsigned* st) {
    XcdBarrier b; b.bar = bar; b.x = xb_xcc_id(); b.st = st;
    if (threadIdx.x == 0) (void)xb_add(&bar[XB_XCNT(b.x)], 1u);
    return b;
}
__device__ __forceinline__ void xcd_barrier_complete(unsigned* bar, unsigned x, unsigned& nloc, unsigned& nx) {
    const unsigned G = gridDim.x * gridDim.y * gridDim.z;
    unsigned sum, cnt, mine, sp = 0u;
    for (;;) {
        sum = 0u; cnt = 0u; mine = 0u;
#pragma unroll
        for (unsigned j = 0; j < 16; ++j) { const unsigned c = xb_ld(&bar[XB_XCNT(j)]); sum += c; cnt += (c > 0u) ? 1u : 0u; mine = (j == x) ? c : mine; }
        if (sum == G) break;
        __builtin_amdgcn_s_sleep(1);
        if ((++sp & 255u) == 0u) { if (xb_ld(&bar[XB_TMO])) break; if (sp > XB_SPIN_CAP) { atomicAdd(&bar[XB_TMO], 1u); break; } }
    }
    nloc = mine > 0u ? mine : 1u; nx = cnt > 0u ? cnt : 1u;
}
__device__ __forceinline__ void xcd_barrier(const XcdBarrier& b) {
    asm volatile("s_waitcnt vmcnt(0)" ::: "memory");
    __syncthreads();
    if (threadIdx.x == 0) {
        unsigned* bar = b.bar;
        __builtin_amdgcn_s_waitcnt(0);
        unsigned nloc = b.st[0], nx = b.st[1];
        if (nloc == 0u) { xcd_barrier_complete(bar, b.x, nloc, nx); b.st[0] = nloc; b.st[1] = nx; }
        const unsigned old = xb_add(&bar[XB_XSUB(b.x)], 1u);
        const unsigned gen = old / nloc;
        if (old + 1u == (gen + 1u) * nloc) {
            __builtin_amdgcn_fence(__ATOMIC_RELEASE, "agent");
            asm volatile("s_waitcnt vmcnt(0)" ::: "memory");
            const unsigned og = xb_add(&bar[XB_TOP], 1u);
            const unsigned tg = og / nx;
            if (og + 1u == (tg + 1u) * nx) xb_add(&bar[XB_TOPGEN], 1u);
            else XB_SPIN(xb_ld(&bar[XB_TOPGEN]) == tg, bar);
            __builtin_amdgcn_fence(__ATOMIC_ACQUIRE, "agent");
            xb_add(&bar[XB_XGEN(b.x)], 1u);
            asm volatile("s_waitcnt vmcnt(0)" ::: "memory");
        } else {
            XB_SPIN(xb_ld(&bar[XB_XGEN(b.x)]) == gen, bar);
            __builtin_amdgcn_fence(__ATOMIC_ACQUIRE, "agent");
            asm volatile("s_waitcnt vmcnt(0)" ::: "memory");
        }
    }
    __syncthreads();
}

constexpr int N_PHASES = 2 + 6 * NLAYER;
__global__ void __launch_bounds__(512, 2) mega(Params P0) {
    extern __shared__ __attribute__((aligned(16))) unsigned char smem[];
    LAS unsigned char* lds = (LAS unsigned char*)smem;
    cg::grid_group grid = cg::this_grid();
    const int lo = P0.ph_lo, hi = P0.ph_hi;
    volatile LAS unsigned* xst = (volatile LAS unsigned*)(lds + 131072 + 16);
    if (threadIdx.x == 0) { xst[0] = 0u; xst[1] = 0u; }
    __syncthreads();
    const XcdBarrier xbar = xcd_barrier_post((unsigned*)(P0.ws + WS_BAR), xst);
#ifndef PH_MASK
#define PH_MASK 0xff
#endif
#ifndef DUP_MASK
#define DUP_MASK 0
#endif
#ifndef EXTRA_SYNC
#define EXTRA_SYNC 0
#endif
#define NDUP(bit) ((DUP_MASK & (bit)) ? 2 : 1)
#define IN(k) (lo <= (k) && (k) < hi)
#define SEAM(k) do { if (IN(k) && IN((k) + 1)) { if ((k) == 0) grid.sync(); else xcd_barrier(xbar); if (EXTRA_SYNC) xcd_barrier(xbar); } } while (0)
#define FRESH() Params P = P0; { unsigned char* w_ = P0.ws; asm volatile("" : "+s"(w_)); P.ws = w_; } unsigned char* ws = P.ws; (void)ws; const int G = my_G(), bx = my_bx(); (void)G; (void)bx
    if ((PH_MASK & 1) && IN(0)) { for (int d = 0; d < NDUP(1); ++d) { FRESH(); phase_prologue(P, lds, d); if (d + 1 < NDUP(1)) grid.sync(); } SEAM(0); }
#pragma unroll 1
    for (int l = 0; l < NLAYER; ++l) {
        const int p0 = 1 + 6 * l;
        if ((PH_MASK & 2) && IN(p0)) { FRESH(); phase_ln(P, l); SEAM(p0); }
        if ((PH_MASK & 4) && IN(p0 + 1)) {
            FRESH(); unsigned char* wl = ws + WS_W + (size_t)l * SZ_WL;
            __syncthreads();
            pg8::Gemm g{(const bf16_t*)(ws + WS_U), (const bf16_t*)wl, T, N1, DM}; pg8::StaticOrder S; S.init(T, N1, G, bx);
            Epi1 E{ws};
            for (int d = 0; d < NDUP(4); ++d) { pg8::gemm_phase<Epi1, pg8::StaticOrder, true, true>(lds, g, S, E); if (d + 1 < NDUP(4)) grid.sync(); }
            SEAM(p0 + 1);
        }
        if ((PH_MASK & 8) && IN(p0 + 2)) {
            { FRESH(); phase_small(P, l); }
            __syncthreads();
            { FRESH(); unsigned char* wl = ws + WS_W + (size_t)l * SZ_WL;
              pg8::Gemm g{(const bf16_t*)(ws + WS_CQ), (const bf16_t*)(wl + OFF_BT2Q), T, 1536, 512}; pg8::StaticOrder S; S.init(T, 1536, G, bx);
              Epi2<0> E{ws}; pg8::gemm_phase<Epi2<0>, pg8::StaticOrder, false, true>(lds, g, S, E); }
            __syncthreads();
            { FRESH(); unsigned char* wl = ws + WS_W + (size_t)l * SZ_WL;
              pg8::Gemm g{(const bf16_t*)(ws + WS_CKV), (const bf16_t*)(wl + OFF_BT2KV), T, 2048, 256}; pg8::StaticOrder S; S.init(T, 2048, G, bx);
              Epi2<1> E{ws}; pg8::gemm_phase<Epi2<1>, pg8::StaticOrder, false, true>(lds, g, S, E); }
            SEAM(p0 + 2);
        }
        if ((PH_MASK & 16) && IN(p0 + 3)) { for (int d = 0; d < NDUP(16); ++d) { FRESH(); phase_attn(P, lds); if (d + 1 < NDUP(16)) grid.sync(); } SEAM(p0 + 3); }
        if ((PH_MASK & 32) && IN(p0 + 4)) {
            FRESH(); unsigned char* wl = ws + WS_W + (size_t)l * SZ_WL;
            __syncthreads();
            pg8::Gemm g{(const bf16_t*)(ws + WS_YS), (const bf16_t*)(wl + OFF_BT3), 3 * T, 3 * 2048, 1024}; pg8::BranchOrder S; S.so.init(T, 2048, G, bx);
            Epi3 E{ws};
            pg8::gemm_phase<Epi3, pg8::BranchOrder, true, true>(lds, g, S, E);
            SEAM(p0 + 4);
        }
        if ((PH_MASK & 64) && IN(p0 + 5)) {
            FRESH(); unsigned char* wl = ws + WS_W + (size_t)l * SZ_WL;
            __syncthreads();
            pg8::Gemm g{(const bf16_t*)(ws + WS_MRG), (const bf16_t*)(wl + OFF_BT4), T, 2048, 2048}; pg8::StaticOrder S; S.init(T, 2048, G, bx);
            Epi4 E{(bf16_t*)(ws + WS_MRG2)};
            pg8::gemm_phase<Epi4, pg8::StaticOrder, false, true>(lds, g, S, E);
            SEAM(p0 + 5);
        }
    }
    if ((PH_MASK & 2) && IN(N_PHASES - 1)) { FRESH(); phase_ln(P, 4); }
#undef IN
#undef SEAM
#undef FRESH
}

extern "C" void kernel_launch(void* const* d_in, const int* in_sizes, int n_in, void* d_out, int out_size, void* d_ws, size_t ws_size, hipStream_t stream) {
    static int grid = 0;
    if (grid == 0) {
        if (n_in != 15 || ws_size < WS_END) { fprintf(stderr, "kernel_launch: bad inputs (n_in %d, ws %zu < %zu)\n", n_in, ws_size, (size_t)WS_END); grid = -1; return; }
        int dev = 0, cus = 0, per_cu = 0;
        hipGetDevice(&dev); hipDeviceGetAttribute(&cus, hipDeviceAttributeMultiprocessorCount, dev);
        if (hipFuncSetAttribute((const void*)mega, hipFuncAttributeMaxDynamicSharedMemorySize, LDS_BYTES) != hipSuccess) { fprintf(stderr, "kernel_launch: hipFuncSetAttribute failed\n"); grid = -1; return; }
        if (hipOccupancyMaxActiveBlocksPerMultiprocessor(&per_cu, (const void*)mega, 512, LDS_BYTES) != hipSuccess || per_cu < 1) { fprintf(stderr, "kernel_launch: occupancy query says %d\n", per_cu); per_cu = 1; }
        (void)hipGetLastError();
        grid = cus * per_cu;
    }
    if (grid < 0) return;
    (void)hipMemsetAsync((char*)d_ws + WS_CTR, 0, WS_ZERO_BYTES, stream);
    Params p{};
    p.x = (const float*)d_in[0]; p.c = (const float*)d_in[1]; p.pos = (const int*)d_in[2]; p.w_ada = (const float*)d_in[3]; p.b_ada = (const float*)d_in[4]; p.w_in = (const float*)d_in[5];
    p.qng = (const float*)d_in[6]; p.kvng = (const float*)d_in[7]; p.w_uq = (const float*)d_in[8]; p.w_ukv = (const float*)d_in[9]; p.fox_bias = (const float*)d_in[10];
    p.w_branch = (const float*)d_in[11]; p.w_out = (const float*)d_in[12]; p.ln_g = (const float*)d_in[13]; p.ln_b = (const float*)d_in[14];
    p.out = (float*)d_out; p.ws = (unsigned char*)d_ws;
#if PER_PHASE_LAUNCH
    for (int ph = 0; ph < N_PHASES; ++ph) { p.ph_lo = ph; p.ph_hi = ph + 1; hipLaunchKernelGGL(mega, dim3(grid), dim3(512), LDS_BYTES, stream, p); }
#else
    p.ph_lo = 0; p.ph_hi = N_PHASES;
    void* args[] = {&p};
    hipError_t e = hipLaunchCooperativeKernel((const void*)mega, dim3(grid), dim3(512), args, LDS_BYTES, stream);
    if (e != hipSuccess) fprintf(stderr, "kernel_launch: cooperative launch failed: %s (grid %d)\n", hipGetErrorString(e), grid);
#endif
}
```

```cpp
#include <hip/hip_runtime.h>
#include <hip/hip_cooperative_groups.h>
#include <cstdio>
#include <cstdint>
#include <cmath>
namespace cg = cooperative_groups;

#ifndef PER_PHASE_LAUNCH
#define PER_PHASE_LAUNCH 0
#endif

#define LAS __attribute__((address_space(3)))
typedef unsigned short bf16_t;
typedef short bf16x8 __attribute__((ext_vector_type(8)));
typedef float f32x4 __attribute__((ext_vector_type(4)));
typedef float f32x2 __attribute__((ext_vector_type(2)));
typedef float f32x16 __attribute__((ext_vector_type(16)));
typedef unsigned u32x4 __attribute__((ext_vector_type(4)));
typedef unsigned u32x2 __attribute__((ext_vector_type(2)));
typedef __bf16 bf16x2_t __attribute__((ext_vector_type(2)));

constexpr int T = 8192, DM = 2048, SEQ = 2048, NBATCH = 4, NLAYER = 4, DIN = 16200, N1 = 16384;
constexpr float LOG2E = 1.4426950408889634f;
constexpr float ALPHA = 1.681792830507429f;
constexpr int LDS_BYTES = 131072 + 1024;

constexpr size_t al256(size_t x) { return (x + 255) & ~(size_t)255; }
constexpr size_t SZ_BT1 = (size_t)N1 * DM * 2, SZ_BT2Q = (size_t)1536 * 512 * 2, SZ_BT2KV = (size_t)2048 * 256 * 2, SZ_BT3 = (size_t)3 * 2048 * 1024 * 2, SZ_BT4 = (size_t)2048 * 2048 * 2;
constexpr size_t OFF_BT2Q = SZ_BT1, OFF_BT2KV = OFF_BT2Q + SZ_BT2Q, OFF_BT3 = OFF_BT2KV + SZ_BT2KV, OFF_BT4 = OFF_BT3 + SZ_BT3, SZ_WL = OFF_BT4 + SZ_BT4;
constexpr size_t WS_CTR = 0;
constexpr size_t WS_BAR = 256;
constexpr size_t WS_ZERO_BYTES = 256 + 16384;
constexpr size_t WS_W = WS_ZERO_BYTES;
constexpr size_t WS_MOD = al256(WS_W + NLAYER * SZ_WL);
constexpr size_t WS_CS = al256(WS_MOD + (size_t)NLAYER * 4 * 6144 * 4);
constexpr size_t WS_U = al256(WS_CS + (size_t)T * 32 * 8);
constexpr size_t WS_X = al256(WS_U + (size_t)T * DM * 2);
constexpr size_t WS_Y = al256(WS_X + (size_t)T * DM * 4);
constexpr size_t WS_MRG2 = WS_Y;
constexpr size_t WS_CQ = al256(WS_Y + (size_t)T * DM * 4);
constexpr size_t WS_CKV = al256(WS_CQ + (size_t)T * 512 * 2);
constexpr size_t WS_SSQ = al256(WS_CKV + (size_t)T * 256 * 2);
constexpr size_t WS_SG = al256(WS_SSQ + (size_t)T * 16 * 4);
constexpr size_t SZ_TH = (size_t)T * 1024 * 2;
constexpr size_t WS_QB = al256(WS_SG + 3 * SZ_TH), WS_KB = WS_QB + SZ_TH, WS_VBT = WS_KB + SZ_TH, WS_QC = WS_VBT + SZ_TH, WS_KC = WS_QC + SZ_TH, WS_VCT = WS_KC + SZ_TH;
constexpr size_t WS_QAN = WS_VCT + SZ_TH, WS_KAN = WS_QAN + SZ_TH, WS_VAT = WS_KAN + SZ_TH;
constexpr size_t WS_QAR = WS_VAT + SZ_TH;
constexpr size_t WS_KR = al256(WS_QAR + (size_t)T * 512 * 2);
constexpr size_t WS_MISC = al256(WS_KR + (size_t)T * 64 * 2);
constexpr size_t WS_FC = al256(WS_MISC + (size_t)T * 128 * 4);
constexpr size_t WS_MG = al256(WS_FC + (size_t)32 * 2048 * 4);
constexpr size_t WS_YS = al256(WS_MG + (size_t)T * 6144 * 2);
constexpr size_t WS_MACC = al256(WS_YS + 3 * SZ_TH);
constexpr size_t WS_MRG = al256(WS_MACC + (size_t)T * DM * 4);
constexpr size_t WS_END = al256(WS_MRG + (size_t)T * DM * 2);

struct Params {
    const float* x; const float* c; const int* pos; const float* w_ada; const float* b_ada; const float* w_in;
    const float* qng; const float* kvng; const float* w_uq; const float* w_ukv; const float* fox_bias;
    const float* w_branch; const float* w_out; const float* ln_g; const float* ln_b;
    float* out; unsigned char* ws;
    int ph_lo, ph_hi;
};

__device__ __forceinline__ unsigned pk2(float lo, float hi) { f32x2 v = {lo, hi}; bf16x2_t b = __builtin_convertvector(v, bf16x2_t); return __builtin_bit_cast(unsigned, b); }
__device__ __forceinline__ bf16_t f2bf(float x) { return (bf16_t)(pk2(x, 0.f) & 0xffffu); }
__device__ __forceinline__ float bf2f(bf16_t b) { return __uint_as_float(((unsigned)b) << 16); }
__device__ __forceinline__ float wave_sum(float v) {
#pragma unroll
    for (int o = 32; o >= 1; o >>= 1) v += __shfl_xor(v, o);
    return v;
}
__device__ __forceinline__ float sigmoidf_(float x) { return __builtin_amdgcn_rcpf(1.f + __expf(-x)); }
__device__ __forceinline__ float siluf_(float x) { return x * sigmoidf_(x); }
__device__ __forceinline__ float exp2_(float x) { return __builtin_amdgcn_exp2f(x); }
__device__ __forceinline__ float log2_(float x) { return __builtin_amdgcn_logf(x); }
__device__ __forceinline__ float max3_(float a, float b, float c) { float r; asm("v_max3_f32 %0, %1, %2, %3" : "=v"(r) : "v"(a), "v"(b), "v"(c)); return r; }
__device__ __forceinline__ f32x2 pk_sub(f32x2 a, f32x2 b) { f32x2 r; asm("v_pk_add_f32 %0, %1, %2 neg_lo:[0,1] neg_hi:[0,1]" : "=v"(r) : "v"(a), "v"(b)); return r; }
__device__ __forceinline__ f32x2 pk_add(f32x2 a, f32x2 b) { f32x2 r; asm("v_pk_add_f32 %0, %1, %2" : "=v"(r) : "v"(a), "v"(b)); return r; }
__device__ __forceinline__ float swap_max(float x) { auto rr = __builtin_amdgcn_permlane32_swap(__float_as_uint(x), __float_as_uint(x), false, false); return fmaxf(__uint_as_float(rr[0]), __uint_as_float(rr[1])); }
__device__ __forceinline__ float swap_sum(float x) { auto rr = __builtin_amdgcn_permlane32_swap(__float_as_uint(x), __float_as_uint(x), false, false); return __uint_as_float(rr[0]) + __uint_as_float(rr[1]); }
__device__ __forceinline__ float swap_partner(float x, int hh) { auto rr = __builtin_amdgcn_permlane32_swap(__float_as_uint(x), __float_as_uint(x), false, false); return __uint_as_float(hh ? rr[0] : rr[1]); }

__device__ __forceinline__ int my_tid() { int t = threadIdx.x; asm volatile("" : "+v"(t)); return t; }
__device__ __forceinline__ int my_bx() { int b = blockIdx.x; asm volatile("" : "+s"(b)); return b; }
__device__ __forceinline__ int my_G() { int g = gridDim.x; asm volatile("" : "+s"(g)); return g; }
namespace pg8 {
#define PG8_LAS __attribute__((address_space(3)))
constexpr int BM = 256, BK = 64, HALF = 128, HTB = HALF * BK * 2, STAGE_BYTES = 8 * HTB, NXCD = 8, WGM = 8;
__host__ __device__ __forceinline__ int lds_byte(int r, int c) { const int st = (r >> 4) * 2 + (c >> 5), rr = r & 15, cc = c & 31, ob = rr * 64 + cc * 2; return st * 1024 + (ob ^ (((ob >> 9) & 1) << 5)); }
__host__ __device__ __forceinline__ void stage_rc(int b, int& R, int& C) { const int st = b / 1024, sb = b % 1024, swz = sb ^ (((sb >> 9) & 1) << 5); R = (st >> 1) * 16 + swz / 64; C = (st & 1) * 32 + (swz % 64) / 2; }
__host__ __device__ __forceinline__ int perm32(int rho) { const int n = rho >> 4, i = rho & 15; return 8 * (i >> 2) + 4 * n + (i & 3); }
struct Unit { int pm, pn; };
struct Gemm { const bf16_t* A; const bf16_t* Bt; int M, N, K; };
struct StaticOrder {
    int nM, nN, nwg, G, c;
    __host__ __device__ void init(int M, int N, int G_, int c_) { nM = M / BM; nN = N / BM; nwg = nM * nN; G = G_; c = c_; }
    __host__ __device__ bool next(int i, Unit& u) const {
        const long L = (long)i * G + c; if (L >= nwg) return false;
        int wgid = (int)L; { const int q = nwg / NXCD, r = nwg % NXCD, xcd = wgid % NXCD, off = wgid / NXCD; wgid = (xcd < r ? xcd * (q + 1) : r * (q + 1) + (xcd - r) * q) + off; }
        const int nig = WGM * nN, gid = wgid / nig, fm = gid * WGM, gsz = (nM - fm) < WGM ? (nM - fm) : WGM;
        u.pm = fm + ((wgid % nig) % gsz); u.pn = (wgid % nig) / gsz; return true;
    }
    __device__ __forceinline__ void a_ready(const Unit&) const {}
    __device__ __forceinline__ void done(const Unit&) const {}
};
struct BranchOrder {
    StaticOrder so;
    __device__ bool next(int i, Unit& u) const { Unit t; if (!so.next(i / 3, t)) return false; const int n = i % 3; u.pm = n * 32 + t.pm; u.pn = n * 8 + t.pn; return true; }
    __device__ __forceinline__ void a_ready(const Unit&) const {}
    __device__ __forceinline__ void done(const Unit&) const {}
};

template <class Epi, class Sched, bool ALIGN_EPI = false, bool SP2 = false>
__device__ __forceinline__ void gemm_phase(PG8_LAS unsigned char* lds, const Gemm g, const Sched& S, const Epi& E) {
    const int tid = my_tid(), wid = __builtin_amdgcn_readfirstlane(tid >> 6), lane = tid & 63, wr = wid >> 2, wc = wid & 3, fr = lane & 15, fq = lane >> 4;
    const int K = g.K, nt = K / BK;
    unsigned voffA[2], voffB[2];
#pragma unroll
    for (int i = 0; i < 2; ++i) { int R, C; stage_rc(tid * 16 + i * 8192, R, C); const int Rb = Epi::PERM ? ((R & ~31) + perm32(R & 31)) : R;
        voffA[i] = (unsigned)(R * K + C) * 2u; voffB[i] = (unsigned)(Rb * K + C) * 2u; }
    const size_t kstep = (size_t)(BK * 2);
    const size_t hstep = (size_t)HALF * K * 2;
    const size_t tstep = 2 * hstep;
    const unsigned ldsw = (unsigned)wid * 1024u;
    const int aoff = lds_byte(wr * 64 + fr, fq * 8), boff = lds_byte(wc * 32 + fr, fq * 8);
#define PG8_SA(b, h) (((b) * 2 + (h)) * HTB)
#define PG8_SB(b, h) ((4 + (b) * 2 + (h)) * HTB)
#define PG8_STAGE(bufoff, gbase, voff) do { _Pragma("unroll") for (int _i = 0; _i < 2; ++_i) \
        __builtin_amdgcn_global_load_lds((const unsigned*)((const char*)(gbase) + (voff)[_i]), (PG8_LAS unsigned*)(lds + (bufoff) + ldsw + _i * 8192), 16, 0, 0); } while (0)
#define PG8_LDA(dst, b, h) do { _Pragma("unroll") for (int m = 0; m < 4; ++m) _Pragma("unroll") for (int k = 0; k < 2; ++k) dst[m][k] = *(const PG8_LAS bf16x8*)(lds + PG8_SA(b, h) + aoff + m * 2048 + k * 1024); } while (0)
#define PG8_LDB(dst, b, h) do { _Pragma("unroll") for (int n = 0; n < 2; ++n) _Pragma("unroll") for (int k = 0; k < 2; ++k) dst[n][k] = *(const PG8_LAS bf16x8*)(lds + PG8_SB(b, h) + boff + n * 2048 + k * 1024); } while (0)
#define PG8_MMA(ai, bj, At, Bt) do { __builtin_amdgcn_s_setprio(1); _Pragma("unroll") for (int m = 0; m < 4; ++m) _Pragma("unroll") for (int n = 0; n < 2; ++n) _Pragma("unroll") for (int k = 0; k < 2; ++k) \
        acc[ai][bj][m][n] = __builtin_amdgcn_mfma_f32_16x16x32_bf16(Bt[n][k], At[m][k], acc[ai][bj][m][n], 0, 0, 0); __builtin_amdgcn_s_setprio(0); } while (0)
#define PG8_WAIT_V(n) asm volatile("s_waitcnt vmcnt(" #n ")" ::: "memory")
#define PG8_WAIT_L(n) asm volatile("s_waitcnt lgkmcnt(" #n ")" ::: "memory")
#define PG8_BAR __builtin_amdgcn_s_barrier()
#define PG8_SCHED __builtin_amdgcn_sched_barrier(0)
    Unit cur, nxt; int ui = 0;
    if (!S.next(0, cur)) return;
    f32x4 acc[2][2][4][2];
#pragma unroll
    for (int a = 0; a < 2; ++a)
#pragma unroll
        for (int b = 0; b < 2; ++b)
#pragma unroll
            for (int m = 0; m < 4; ++m)
#pragma unroll
                for (int n = 0; n < 2; ++n) acc[a][b][m][n] = (f32x4){0.f, 0.f, 0.f, 0.f};
    bf16x8 At[4][2], B0[2][2], B1[2][2];
    const char* cA = (const char*)g.A + (size_t)cur.pm * tstep; const char* cB = (const char*)g.Bt + (size_t)cur.pn * tstep;
    S.a_ready(cur);
    if constexpr (SP2) {
        PG8_STAGE(PG8_SB(0, 0), cB, voffB); PG8_STAGE(PG8_SB(0, 1), cB + hstep, voffB); PG8_STAGE(PG8_SA(0, 0), cA, voffA); PG8_STAGE(PG8_SA(0, 1), cA + hstep, voffA);
        if (wr == 1) PG8_BAR;
        PG8_WAIT_V(2); PG8_BAR;
        PG8_STAGE(PG8_SB(1, 0), cB + kstep, voffB); PG8_STAGE(PG8_SA(1, 0), cA + kstep, voffA); PG8_STAGE(PG8_SB(1, 1), cB + hstep + kstep, voffB);
        PG8_WAIT_V(6); PG8_BAR;
    } else {
        PG8_STAGE(PG8_SB(0, 0), cB, voffB); PG8_STAGE(PG8_SA(0, 0), cA, voffA); PG8_STAGE(PG8_SB(0, 1), cB + hstep, voffB); PG8_STAGE(PG8_SA(0, 1), cA + hstep, voffA);
        if (wr == 1) PG8_BAR;
        PG8_WAIT_V(4); PG8_BAR;
        PG8_STAGE(PG8_SB(1, 0), cB + kstep, voffB); PG8_STAGE(PG8_SA(1, 0), cA + kstep, voffA); PG8_STAGE(PG8_SB(1, 1), cB + hstep + kstep, voffB);
        PG8_WAIT_V(6); PG8_BAR;
    }
    for (;;) {
        const bool has_next = S.next(ui + 1, nxt);
        const char* nA = has_next ? (const char*)g.A + (size_t)nxt.pm * tstep : cA; const char* nB = has_next ? (const char*)g.Bt + (size_t)nxt.pn * tstep : cB;
#pragma unroll 1
        for (int t = 0; t < nt; t += 2) {
            const bool last = (t == nt - 2);
            const char* a1 = cA + (size_t)(t + 1) * kstep;
            const char* a2 = last ? nA : cA + (size_t)(t + 2) * kstep; const char* b2 = last ? nB : cB + (size_t)(t + 2) * kstep;
            const char* a3 = a2 + kstep; const char* b3 = b2 + kstep;
            if (last && has_next) S.a_ready(nxt);
            if constexpr (SP2) {
            PG8_LDB(B0, 0, 0); PG8_LDB(B1, 0, 1); PG8_SCHED; PG8_LDA(At, 0, 0); PG8_STAGE(PG8_SA(1, 1), a1 + hstep, voffA);
            PG8_WAIT_V(8); PG8_WAIT_L(0); PG8_BAR; PG8_MMA(0, 0, At, B0); PG8_MMA(0, 1, At, B1); PG8_BAR; PG8_SCHED;
            PG8_LDA(At, 0, 1); PG8_STAGE(PG8_SB(0, 0), b2, voffB); PG8_STAGE(PG8_SB(0, 1), b2 + hstep, voffB); PG8_STAGE(PG8_SA(0, 0), a2, voffA);
            PG8_WAIT_V(8); PG8_WAIT_L(0); PG8_BAR; PG8_MMA(1, 0, At, B0); PG8_MMA(1, 1, At, B1); PG8_BAR; PG8_SCHED;
            PG8_LDB(B0, 1, 0); PG8_LDB(B1, 1, 1); PG8_SCHED; PG8_LDA(At, 1, 0); PG8_STAGE(PG8_SA(0, 1), a2 + hstep, voffA);
            PG8_WAIT_V(8); PG8_WAIT_L(0); PG8_BAR; PG8_MMA(0, 0, At, B0); PG8_MMA(0, 1, At, B1); PG8_BAR; PG8_SCHED;
            PG8_LDA(At, 1, 1); PG8_STAGE(PG8_SB(1, 0), b3, voffB); PG8_STAGE(PG8_SB(1, 1), b3 + hstep, voffB); PG8_STAGE(PG8_SA(1, 0), a3, voffA);
            PG8_WAIT_V(8); PG8_WAIT_L(0); PG8_BAR; PG8_MMA(1, 0, At, B0); PG8_MMA(1, 1, At, B1); PG8_BAR; PG8_SCHED;
            } else {
            PG8_LDB(B0, 0, 0); PG8_SCHED; PG8_LDA(At, 0, 0); PG8_STAGE(PG8_SA(1, 1), a1 + hstep, voffA);
            PG8_WAIT_L(8); PG8_BAR; PG8_WAIT_L(0); PG8_MMA(0, 0, At, B0); PG8_BAR; PG8_SCHED;
            PG8_LDB(B1, 0, 1); PG8_STAGE(PG8_SB(0, 0), b2, voffB);
            PG8_BAR; PG8_WAIT_L(0); PG8_MMA(0, 1, At, B1); PG8_BAR;
            PG8_LDA(At, 0, 1); PG8_STAGE(PG8_SA(0, 0), a2, voffA);
            PG8_BAR; PG8_WAIT_L(0); PG8_MMA(1, 0, At, B0); PG8_BAR; PG8_SCHED;
            PG8_STAGE(PG8_SB(0, 1), b2 + hstep, voffB);
            PG8_WAIT_V(6); PG8_BAR; PG8_MMA(1, 1, At, B1); PG8_BAR;
            PG8_LDB(B0, 1, 0); PG8_SCHED; PG8_LDA(At, 1, 0); PG8_STAGE(PG8_SA(0, 1), a2 + hstep, voffA);
            PG8_WAIT_L(8); PG8_BAR; PG8_WAIT_L(0); PG8_MMA(0, 0, At, B0); PG8_BAR; PG8_SCHED;
            PG8_LDB(B1, 1, 1); PG8_STAGE(PG8_SB(1, 0), b3, voffB);
            PG8_BAR; PG8_WAIT_L(0); PG8_MMA(0, 1, At, B1); PG8_BAR;
            PG8_LDA(At, 1, 1); PG8_STAGE(PG8_SA(1, 0), a3, voffA);
            PG8_BAR; PG8_WAIT_L(0); PG8_MMA(1, 0, At, B0); PG8_BAR; PG8_SCHED;
            PG8_STAGE(PG8_SB(1, 1), b3 + hstep, voffB);
            PG8_WAIT_V(6); PG8_BAR; PG8_MMA(1, 1, At, B1); PG8_BAR;
            }
        }
        if constexpr (ALIGN_EPI) { if (wr == 0) PG8_BAR; }
        E(acc, cur, wr, wc, fr, fq); S.done(cur);
        if (!has_next) break;
        if (!E.keep_acc(cur)) {
#pragma unroll
        for (int a = 0; a < 2; ++a)
#pragma unroll
            for (int b = 0; b < 2; ++b)
#pragma unroll
                for (int m = 0; m < 4; ++m)
#pragma unroll
                    for (int n = 0; n < 2; ++n) acc[a][b][m][n] = (f32x4){0.f, 0.f, 0.f, 0.f};
        }
        cur = nxt; cA = nA; cB = nB; ++ui;
        if constexpr (ALIGN_EPI) { if (wr == 1) PG8_BAR; }
    }
    PG8_WAIT_V(0);
    if constexpr (!ALIGN_EPI) { if (wr == 0) PG8_BAR; }
    PG8_BAR;
#undef PG8_SA
#undef PG8_SB
#undef PG8_STAGE
#undef PG8_LDA
#undef PG8_LDB
#undef PG8_MMA
#undef PG8_WAIT_V
#undef PG8_WAIT_L
#undef PG8_BAR
#undef PG8_SCHED
}
}

typedef const f32x4 (&AccRef)[2][2][4][2];
typedef f32x4 (&AccMut)[2][2][4][2];

template <int ACT> __device__ __forceinline__ void store_bf16_tile(AccRef acc, bf16_t* base, int ld, int row0, int cl0) {
#pragma unroll
    for (int ai = 0; ai < 2; ++ai)
#pragma unroll
        for (int m = 0; m < 4; ++m) { bf16_t* rp = base + (size_t)(row0 + ai * 128 + m * 16) * ld + cl0;
#pragma unroll
            for (int bj = 0; bj < 2; ++bj) { f32x4 v0 = acc[ai][bj][m][0], v1 = acc[ai][bj][m][1];
                if (ACT == 1) {
#pragma unroll
                    for (int j = 0; j < 4; ++j) { v0[j] = siluf_(v0[j]); v1[j] = siluf_(v1[j]); } }
                if (ACT == 2) {
#pragma unroll
                    for (int j = 0; j < 4; ++j) { v0[j] = sigmoidf_(v0[j]); v1[j] = sigmoidf_(v1[j]); } }
                u32x4 w; w.x = pk2(v0[0], v0[1]); w.y = pk2(v0[2], v0[3]); w.z = pk2(v1[0], v1[1]); w.w = pk2(v1[2], v1[3]);
                *(u32x4*)(rp + bj * 128) = w; } }
}
__device__ __forceinline__ void store_vt_tile(AccRef acc, bf16_t* VT, int h0, int row0, int cl0, const float* rscale) {
#pragma unroll
    for (int ai = 0; ai < 2; ++ai)
#pragma unroll
        for (int m = 0; m < 4; ++m) { const int row = row0 + ai * 128 + m * 16; const int b = row >> 11, s = row & 2047; const float rs = rscale ? rscale[ai * 4 + m] : 1.f;
#pragma unroll
            for (int bj = 0; bj < 2; ++bj) { const unsigned po = (unsigned)(((b * 8 + h0 + bj) * 128 + cl0) * 2048 + s);
#pragma unroll
                for (int n = 0; n < 2; ++n)
#pragma unroll
                    for (int j = 0; j < 4; ++j) VT[po + (unsigned)((4 * n + j) * 2048)] = f2bf(acc[ai][bj][m][n][j] * rs); }
            asm volatile("" ::: "memory"); }
}

struct Epi1 {
    static constexpr bool PERM = true;
    __device__ __forceinline__ bool keep_acc(const pg8::Unit&) const { return false; }
    unsigned char* ws;
    __device__ __forceinline__ void operator()(AccRef acc, const pg8::Unit& u, int wr, int wc, int fr, int fq) const {
        const int pn = (13 * u.pn) & 63, row0 = u.pm * 256 + wr * 64 + fr, cl0 = wc * 32 + 8 * fq;
        if (pn < 3) {
            bf16_t* base; int ld, slot;
            if (pn < 2) { base = (bf16_t*)(ws + WS_CQ) + pn * 256; ld = 512; slot = pn * 4 + wc; } else { base = (bf16_t*)(ws + WS_CKV); ld = 256; slot = 8 + wc; }
            float* ssq = (float*)(ws + WS_SSQ);
#pragma unroll
            for (int ai = 0; ai < 2; ++ai)
#pragma unroll
                for (int m = 0; m < 4; ++m) { const int row = row0 + ai * 128 + m * 16; bf16_t* rp = base + (size_t)row * ld + cl0; float ss = 0.f;
#pragma unroll
                    for (int bj = 0; bj < 2; ++bj) { const f32x4 v0 = acc[ai][bj][m][0], v1 = acc[ai][bj][m][1];
                        ss += (v0[0] * v0[0] + v0[1] * v0[1]) + (v0[2] * v0[2] + v0[3] * v0[3]) + (v1[0] * v1[0] + v1[1] * v1[1]) + (v1[2] * v1[2] + v1[3] * v1[3]);
                        u32x4 w; w.x = pk2(v0[0], v0[1]); w.y = pk2(v0[2], v0[3]); w.z = pk2(v1[0], v1[1]); w.w = pk2(v1[2], v1[3]);
                        *(u32x4*)(rp + bj * 128) = w; }
                    ss += __shfl_xor(ss, 16); ss += __shfl_xor(ss, 32);
                    if (fq == 0) ssq[(size_t)row * 16 + slot] = ss; }
        } else if (pn == 63) {
            float* misc = (float*)(ws + WS_MISC);
#pragma unroll
            for (int ai = 0; ai < 2; ++ai)
#pragma unroll
                for (int m = 0; m < 4; ++m) { float* rp = misc + (size_t)(row0 + ai * 128 + m * 16) * 128 + cl0;
                    *(f32x4*)(rp) = acc[ai][0][m][0]; *(f32x4*)(rp + 4) = acc[ai][0][m][1]; }
        } else if (pn >= 39) {
            store_bf16_tile<2>(acc, (bf16_t*)(ws + WS_MG) + (pn - 39) * 256, 6144, row0, cl0);
        } else {
            const int seg = (pn - 3) >> 2, ct = (pn - 3) & 3;
            if (seg == 0 || seg == 4 || seg == 8) store_bf16_tile<1>(acc, (bf16_t*)(ws + WS_SG) + (size_t)(seg >> 2) * T * 1024 + ct * 256, 1024, row0, cl0);
            else if (seg == 3) store_vt_tile(acc, (bf16_t*)(ws + WS_VBT), ct * 2, row0, cl0, nullptr);
            else if (seg == 7) store_vt_tile(acc, (bf16_t*)(ws + WS_VCT), ct * 2, row0, cl0, nullptr);
            else { const size_t off = seg == 1 ? WS_QB : seg == 2 ? WS_KB : seg == 5 ? WS_QC : WS_KC; store_bf16_tile<0>(acc, (bf16_t*)(ws + off) + ct * 256, 1024, row0, cl0); }
        }
    }
};

template <int WHICH  > struct Epi2 {
    static constexpr bool PERM = true;
    __device__ __forceinline__ bool keep_acc(const pg8::Unit&) const { return false; }
    unsigned char* ws;
    __device__ __forceinline__ float rstd(int row) const {
        const float* ssq = (const float*)(ws + WS_SSQ) + (size_t)row * 16 + (WHICH ? 8 : 0);
        const f32x4 a = *(const f32x4*)ssq; float s = (a[0] + a[1]) + (a[2] + a[3]);
        if (WHICH == 0) { const f32x4 b = *(const f32x4*)(ssq + 4); s += (b[0] + b[1]) + (b[2] + b[3]); }
        return rsqrtf(s * (WHICH ? (1.f / 256.f) : (1.f / 512.f)) + 1e-6f);
    }
    __device__ __forceinline__ void operator()(AccRef acc, const pg8::Unit& u, int wr, int wc, int fr, int fq) const {
        const int pn = u.pn, row0 = u.pm * 256 + wr * 64 + fr, cl0 = wc * 32 + 8 * fq;
        if (pn < 4) {
            bf16_t* base = (bf16_t*)(ws + (WHICH ? WS_KAN : WS_QAN)) + pn * 256;
#pragma unroll
            for (int ai = 0; ai < 2; ++ai)
#pragma unroll
                for (int m = 0; m < 4; ++m) { const int row = row0 + ai * 128 + m * 16; bf16_t* rp = base + (size_t)row * 1024 + cl0; const float r = rstd(row);
#pragma unroll
                    for (int bj = 0; bj < 2; ++bj) { const f32x4 v0 = acc[ai][bj][m][0] * r, v1 = acc[ai][bj][m][1] * r;
                        u32x4 w; w.x = pk2(v0[0], v0[1]); w.y = pk2(v0[2], v0[3]); w.z = pk2(v1[0], v1[1]); w.w = pk2(v1[2], v1[3]);
                        *(u32x4*)(rp + bj * 128) = w; }
                    asm volatile("" ::: "memory"); }
        } else if (WHICH == 1) {
            bf16_t* VT = (bf16_t*)(ws + WS_VAT); const int h0 = (pn - 4) * 2;
#pragma unroll
            for (int ai = 0; ai < 2; ++ai)
#pragma unroll
                for (int m = 0; m < 4; ++m) { const int row = row0 + ai * 128 + m * 16; const int b = row >> 11, s = row & 2047; const float rs = rstd(row);
#pragma unroll
                    for (int bj = 0; bj < 2; ++bj) { const unsigned po = (unsigned)(((b * 8 + h0 + bj) * 128 + cl0) * 2048 + s);
#pragma unroll
                        for (int n = 0; n < 2; ++n)
#pragma unroll
                            for (int j = 0; j < 4; ++j) VT[po + (unsigned)((4 * n + j) * 2048)] = f2bf(acc[ai][bj][m][n][j] * rs); }
                    asm volatile("" ::: "memory"); }
        } else {
            bf16_t* base = (bf16_t*)(ws + WS_QAR) + (pn - 4) * 256;
            const f32x2* cs = (const f32x2*)(ws + WS_CS);
#pragma unroll
            for (int ai = 0; ai < 2; ++ai)
#pragma unroll
                for (int m = 0; m < 4; ++m) { const int row = row0 + ai * 128 + m * 16; bf16_t* rp = base + (size_t)row * 512 + cl0; const float r = rstd(row);
#pragma unroll
                    for (int bj = 0; bj < 2; ++bj) { const int j0 = ((bj * 128 + cl0) & 63) >> 1;
                        const f32x4 c01 = *(const f32x4*)(cs + (size_t)row * 32 + j0), c23 = *(const f32x4*)(cs + (size_t)row * 32 + j0 + 2);
                        const f32x4 v0 = acc[ai][bj][m][0] * r, v1 = acc[ai][bj][m][1] * r;
                        u32x4 w;
                        w.x = pk2(v0[0] * c01[0] - v0[1] * c01[1], v0[1] * c01[0] + v0[0] * c01[1]);
                        w.y = pk2(v0[2] * c01[2] - v0[3] * c01[3], v0[3] * c01[2] + v0[2] * c01[3]);
                        w.z = pk2(v1[0] * c23[0] - v1[1] * c23[1], v1[1] * c23[0] + v1[0] * c23[1]);
                        w.w = pk2(v1[2] * c23[2] - v1[3] * c23[3], v1[3] * c23[2] + v1[2] * c23[3]);
                        *(u32x4*)(rp + bj * 128) = w; }
                    asm volatile("" ::: "memory"); }
        }
    }
};

__device__ __forceinline__ void unpack_gate(const u32x4 gw, f32x4& g0, f32x4& g1) {
    g0[0] = __uint_as_float(gw.x << 16); g0[1] = __uint_as_float(gw.x & 0xffff0000u); g0[2] = __uint_as_float(gw.y << 16); g0[3] = __uint_as_float(gw.y & 0xffff0000u);
    g1[0] = __uint_as_float(gw.z << 16); g1[1] = __uint_as_float(gw.z & 0xffff0000u); g1[2] = __uint_as_float(gw.w << 16); g1[3] = __uint_as_float(gw.w & 0xffff0000u);
}
struct Epi3 {
    static constexpr bool PERM = true;
    __device__ __forceinline__ bool keep_acc(const pg8::Unit& u) const { return (u.pm >> 5) < 2; }
    unsigned char* ws;
    __device__ __forceinline__ void operator()(AccMut acc, const pg8::Unit& u, int wr, int wc, int fr, int fq) const {
        const int n = u.pm >> 5, pm = u.pm & 31, pn = u.pn & 7;
        const int row0 = pm * 256 + wr * 64 + fr, col0 = pn * 256 + wc * 32 + 8 * fq;
        const bf16_t* mg = (const bf16_t*)(ws + WS_MG) + n * 2048; bf16_t* mrg = (bf16_t*)(ws + WS_MRG);
#pragma unroll
        for (int ai = 0; ai < 2; ++ai)
#pragma unroll
            for (int m = 0; m < 4; ++m) { const int row = row0 + ai * 128 + m * 16;
#pragma unroll
                for (int bj = 0; bj < 2; ++bj) { const int col = col0 + bj * 128;
                    f32x4 g0, g1; unpack_gate(*(const u32x4*)(mg + (size_t)row * 6144 + col), g0, g1);
#pragma unroll
                    for (int j = 0; j < 4; ++j) { g0[j] = fmaxf(g0[j], 1e-20f); g1[j] = fmaxf(g1[j], 1e-20f); }
                    if (n < 2) { f32x4 h0, h1; unpack_gate(*(const u32x4*)(mg + (size_t)row * 6144 + 2048 + col), h0, h1);
#pragma unroll
                        for (int j = 0; j < 4; ++j) { g0[j] *= __builtin_amdgcn_rcpf(fmaxf(h0[j], 1e-20f)); g1[j] *= __builtin_amdgcn_rcpf(fmaxf(h1[j], 1e-20f)); }
                        acc[ai][bj][m][0] *= g0; acc[ai][bj][m][1] *= g1;
                    } else {
                        const f32x4 v0 = acc[ai][bj][m][0] * g0, v1 = acc[ai][bj][m][1] * g1;
                        u32x4 w; w.x = pk2(v0[0], v0[1]); w.y = pk2(v0[2], v0[3]); w.z = pk2(v1[0], v1[1]); w.w = pk2(v1[2], v1[3]); *(u32x4*)(mrg + (size_t)row * 2048 + col) = w; } } }
    }
};

struct Epi4 {
    static constexpr bool PERM = true;
    __device__ __forceinline__ bool keep_acc(const pg8::Unit&) const { return false; }
    bf16_t* O;
    __device__ __forceinline__ void operator()(AccRef acc, const pg8::Unit& u, int wr, int wc, int fr, int fq) const {
        store_bf16_tile<0>(acc, O + u.pn * 256, 2048, u.pm * 256 + wr * 64 + fr, wc * 32 + 8 * fq);
    }
};

__device__ __forceinline__ int map_bt1(int n, float& sc) {
    n = (((13 * (n >> 8)) & 63) << 8) | (n & 255);
    sc = 1.f;
    if (n < 768) return n;
    if (n < 1792) return 832 + (n - 768);
    if (n < 2816) { sc = LOG2E * 0.08838834764831845f; return 1856 + (n - 1792); }
    if (n < 3840) return 2880 + (n - 2816);
    if (n < 4864) return 3904 + (n - 3840);
    if (n < 5888) return 4936 + (n - 4864);
    if (n < 6912) { sc = LOG2E * 0.08838834764831845f; return 5960 + (n - 5888); }
    if (n < 7936) return 6984 + (n - 6912);
    if (n < 8960) return 8008 + (n - 7936);
    if (n < 9984) return 9032 + (n - 8960);
    if (n < 16128) return 10056 + (n - 9984);
    const int r = n - 16128;
    if (r < 64) return 768 + 32 * (r & 1) + (r >> 1);
    if (r < 72) return 4928 + (r - 64);
    return -1;
}
constexpr int CT_BT1 = 128 * 16, CT_BT2Q = 12 * 4, CT_BT2KV = 16 * 2, CT_BT3 = 3 * 16 * 8, CT_BT4 = 16 * 16, CT_LAYER = CT_BT1 + CT_BT2Q + CT_BT2KV + CT_BT3 + CT_BT4;
constexpr int NJ_MOD = 192, NJ_CS = 64, NJ_CONV = NLAYER * CT_LAYER, NJ_TOTAL = NJ_MOD + NJ_CS + NJ_CONV;

__device__ __forceinline__ void conv_tile(const Params& P, int job, LAS unsigned char* lds) {
    const int tid = my_tid();
    const int l = job / CT_LAYER; int r = job % CT_LAYER;
    unsigned char* wl = P.ws + WS_W + (size_t)l * SZ_WL;
    int kind, nt, kt; const float* src; int ld; bf16_t* dst; int Kd; const float* gain = nullptr; float gsc = 1.f;
    if (r < CT_BT1) { kind = 0; nt = r >> 4; kt = r & 15; src = P.w_in + (size_t)l * DM * DIN; ld = DIN; dst = (bf16_t*)wl; Kd = 2048; }
    else if ((r -= CT_BT1) < CT_BT2Q) { kind = 1; nt = r >> 2; kt = r & 3; src = P.w_uq + (size_t)l * 512 * 1536; ld = 1536; dst = (bf16_t*)(wl + OFF_BT2Q); Kd = 512; gain = P.qng + l * 512; gsc = LOG2E * 0.07216878364870323f; }
    else if ((r -= CT_BT2Q) < CT_BT2KV) { kind = 2; nt = r >> 1; kt = r & 1; src = P.w_ukv + (size_t)l * 256 * 2048; ld = 2048; dst = (bf16_t*)(wl + OFF_BT2KV); Kd = 256; gain = P.kvng + l * 256; }
    else if ((r -= CT_BT2KV) < CT_BT3) { kind = 3; const int br = r >> 7; r &= 127; nt = r >> 3; kt = r & 7; src = P.w_branch + ((size_t)l * 3 + br) * 1024 * 2048; ld = 2048; dst = (bf16_t*)(wl + OFF_BT3) + (size_t)br * 2048 * 1024; Kd = 1024; }
    else { r -= CT_BT3; kind = 4; nt = r >> 4; kt = r & 15; src = P.w_out + (size_t)l * 2048 * 2048; ld = 2048; dst = (bf16_t*)(wl + OFF_BT4); Kd = 2048; }
    const int nl = tid & 127, kb = tid >> 7, n = nt * 128 + nl;
    int sc_col; float sc = 1.f;
    if (kind == 0) sc_col = map_bt1(n, sc);
    else if (kind == 1) { if (n < 1024) sc_col = (n >> 7) * 192 + (n & 127); else { const int q = n - 1024, h = q >> 6, rr = q & 63; sc_col = h * 192 + 128 + 32 * (rr & 1) + (rr >> 1); } sc = gsc; }
    else if (kind == 2) { if (n < 1024) sc_col = (n >> 7) * 256 + (n & 127); else { const int q = n - 1024; sc_col = (q >> 7) * 256 + 128 + (q & 127); } }
    else sc_col = n;
    LAS bf16_t* tl = (LAS bf16_t*)lds;
    const float* sp = src + (size_t)(kt * 128 + kb) * ld + (sc_col < 0 ? 0 : sc_col);
    float v[32];
#pragma unroll
    for (int i = 0; i < 32; ++i) v[i] = (sc_col >= 0) ? __builtin_nontemporal_load(sp + (size_t)(4 * i) * ld) : 0.f;
#pragma unroll
    for (int i = 0; i < 32; ++i) { float g = sc; if (gain) g *= gain[kt * 128 + kb + 4 * i]; tl[nl * 130 + kb + 4 * i] = f2bf(v[i] * g); }
    __syncthreads();
    const int nr = tid >> 2, kc = tid & 3;
    const LAS unsigned* rp = (const LAS unsigned*)(lds + (nr * 130 + kc * 32) * 2);
    bf16_t* dp = dst + (size_t)(nt * 128 + nr) * Kd + kt * 128 + kc * 32;
#pragma unroll
    for (int q = 0; q < 4; ++q) { u32x4 w; w.x = rp[4 * q]; w.y = rp[4 * q + 1]; w.z = rp[4 * q + 2]; w.w = rp[4 * q + 3]; *(u32x4*)(dp + 8 * q) = w; }
}

__device__ __forceinline__ void mod_job(const Params& P, int job, LAS unsigned char* lds) {
    const int tid = my_tid(), l = job / 48, ct = job % 48;
    LAS float* cl = (LAS float*)lds;
    LAS float* part = (LAS float*)(lds + 32768);
    for (int i = tid; i < 4 * 2048; i += 512) cl[i] = P.c[i];
    __syncthreads();
    const int col = ct * 128 + (tid & 127), kg = tid >> 7;
    const float* wp = P.w_ada + (size_t)l * 2048 * 6144 + (size_t)(kg * 512) * 6144 + col;
    float a0 = 0.f, a1 = 0.f, a2 = 0.f, a3 = 0.f;
    for (int k = 0; k < 512; k += 8) {
        float w[8];
#pragma unroll
        for (int j = 0; j < 8; ++j) w[j] = __builtin_nontemporal_load(wp + (size_t)(k + j) * 6144);
#pragma unroll
        for (int j = 0; j < 8; ++j) { const int kk = kg * 512 + k + j; a0 += cl[kk] * w[j]; a1 += cl[2048 + kk] * w[j]; a2 += cl[4096 + kk] * w[j]; a3 += cl[6144 + kk] * w[j]; }
    }
    part[(kg * 4 + 0) * 128 + (tid & 127)] = a0; part[(kg * 4 + 1) * 128 + (tid & 127)] = a1; part[(kg * 4 + 2) * 128 + (tid & 127)] = a2; part[(kg * 4 + 3) * 128 + (tid & 127)] = a3;
    __syncthreads();
    { const int b = tid >> 7, c = tid & 127; const float s = part[(0 * 4 + b) * 128 + c] + part[(1 * 4 + b) * 128 + c] + part[(2 * 4 + b) * 128 + c] + part[(3 * 4 + b) * 128 + c];
      ((float*)(P.ws + WS_MOD))[((size_t)l * 4 + b) * 6144 + ct * 128 + c] = s + P.b_ada[(size_t)l * 6144 + ct * 128 + c]; }
}

__device__ __forceinline__ void cs_job(const Params& P, int job) {
    f32x2* cs = (f32x2*)(P.ws + WS_CS);
    const int tid = my_tid();
#pragma unroll
    for (int i = 0; i < 8; ++i) { const int idx = job * 4096 + i * 512 + tid; const int tok = idx >> 5, j = idx & 31;
        double pw = 1.0, bs = 0.749894209332456; { if (j & 1) pw *= bs; bs *= bs; if (j & 2) pw *= bs; bs *= bs; if (j & 4) pw *= bs; bs *= bs; if (j & 8) pw *= bs; bs *= bs; if (j & 16) pw *= bs; }
        const float ang = (float)P.pos[tok] * (float)pw;
        double rev = (double)ang * 0.15915494309189535; rev -= __builtin_rint(rev);
        const float rf = (float)rev;
        cs[idx] = (f32x2){__builtin_amdgcn_cosf(rf), __builtin_amdgcn_sinf(rf)}; }
}

__device__ __forceinline__ void phase_prologue(const Params& P, LAS unsigned char* lds, int ci) {
    const int G = my_G(), c = my_bx();
    if (G == 256) {
        static_assert(NJ_MOD == 192 && NJ_CS == 64 && NJ_CONV == 41 * 256 + 9 * 64, "static prologue deal");
        if (c < NJ_MOD) mod_job(P, c, lds); else cs_job(P, c - NJ_MOD);
#pragma unroll 1
        for (int r = 0; r < 41; ++r) { __syncthreads(); conv_tile(P, r * 256 + c, lds); }
        if (c >= NJ_MOD) {
#pragma unroll 1
            for (int j = 0; j < 9; ++j) { __syncthreads(); conv_tile(P, 41 * 256 + (c - NJ_MOD) + 64 * j, lds); }
        }
        __syncthreads();
        return;
    }
    unsigned* ctr = (unsigned*)(P.ws + WS_CTR) + ci * 16;
    LAS int* slot = (LAS int*)(lds + 131072);
    const int tid0 = my_tid();
    for (;;) {
        __syncthreads();
        if (tid0 == 0) *slot = (int)atomicAdd(ctr, 1u);
        __syncthreads();
        const int job = *slot;
        if (job >= NJ_TOTAL) break;
        if (job < NJ_MOD) mod_job(P, job, lds);
        else if (job < NJ_MOD + NJ_CS) cs_job(P, job - NJ_MOD);
        else conv_tile(P, job - NJ_MOD - NJ_CS, lds);
    }
}

__device__ __forceinline__ void row_stats(const f32x4 (&v)[8], float& mean, float& rstd) {
    float s = 0.f;
#pragma unroll
    for (int i = 0; i < 8; ++i) s += (v[i][0] + v[i][1]) + (v[i][2] + v[i][3]);
    mean = wave_sum(s) * (1.f / 2048.f);
    float q = 0.f;
#pragma unroll
    for (int i = 0; i < 8; ++i) { const f32x4 d = v[i] - mean; q += (d[0] * d[0] + d[1] * d[1]) + (d[2] * d[2] + d[3] * d[3]); }
    rstd = rsqrtf(wave_sum(q) * (1.f / 2048.f) + 1e-5f);
}
__device__ __forceinline__ void phase_ln(const Params& P, int l) {
    const int tid = my_tid(), bx = my_bx(), G = my_G();
    const int wid = tid >> 6, lane = tid & 63;
    float* X = (float*)(P.ws + WS_X); bf16_t* U = (bf16_t*)(P.ws + WS_U);
    const float* xsrc = (l <= 1) ? P.x : X;
    const bf16_t* outb = (const bf16_t*)(P.ws + WS_MRG2);
    const float* g = P.ln_g + (size_t)(l > 0 ? l - 1 : 0) * 2048; const float* bb = P.ln_b + (size_t)(l > 0 ? l - 1 : 0) * 2048;
    const float* mod = (const float*)(P.ws + WS_MOD) + (size_t)(l < 4 ? l : 0) * 4 * 6144;
    const float* gate = (const float*)(P.ws + WS_MOD) + (size_t)(l > 0 ? l - 1 : 0) * 4 * 6144 + 4096;
    for (int row = bx * 8 + wid; row < T; row += G * 8) {
        f32x4 v[8];
#pragma unroll
        for (int i = 0; i < 8; ++i) v[i] = *(const f32x4*)(xsrc + (size_t)row * 2048 + (i * 64 + lane) * 4);
        if (l >= 1) {
            const float* gp = gate + (size_t)(row >> 11) * 6144;
#pragma unroll
            for (int i = 0; i < 8; ++i) { const int col = (i * 64 + lane) * 4; const u32x2 ow = *(const u32x2*)(outb + (size_t)row * 2048 + col); const f32x4 gv = *(const f32x4*)(gp + col);
                f32x4 o; o[0] = __uint_as_float(ow.x << 16); o[1] = __uint_as_float(ow.x & 0xffff0000u); o[2] = __uint_as_float(ow.y << 16); o[3] = __uint_as_float(ow.y & 0xffff0000u);
                v[i] = v[i] * ALPHA + gv * o; }
        }
        float mean, rstd; row_stats(v, mean, rstd);
        if (l >= 1) {
            float* dst = (l == 4) ? P.out : X;
#pragma unroll
            for (int i = 0; i < 8; ++i) { const int col = (i * 64 + lane) * 4; const f32x4 gv = *(const f32x4*)(g + col), bv = *(const f32x4*)(bb + col);
                v[i] = (v[i] - mean) * rstd * gv + bv; *(f32x4*)(dst + (size_t)row * 2048 + col) = v[i]; }
            if (l == 4) continue;
            row_stats(v, mean, rstd);
        }
        const float* mp = mod + (size_t)(row >> 11) * 6144;
#pragma unroll
        for (int i = 0; i < 8; ++i) { const int col = (i * 64 + lane) * 4; const f32x4 sh = *(const f32x4*)(mp + col), sc = *(const f32x4*)(mp + 2048 + col);
            const f32x4 uu = (v[i] - mean) * rstd * (sc + 1.f) + sh; u32x2 w; w.x = pk2(uu[0], uu[1]); w.y = pk2(uu[2], uu[3]);
            *(u32x2*)(U + (size_t)row * 2048 + col) = w; }
    }
}

__device__ __forceinline__ void phase_small(const Params& P, int l) {
    const float* misc = (const float*)(P.ws + WS_MISC); const f32x2* cs = (const f32x2*)(P.ws + WS_CS); bf16_t* kr = (bf16_t*)(P.ws + WS_KR);
    const int tid = my_tid(), bx = my_bx(), G = my_G();
    for (int idx = bx * 512 + tid; idx < T * 32; idx += G * 512) { const int tok = idx >> 5, j = idx & 31;
        const f32x2 x = *(const f32x2*)(misc + (size_t)tok * 128 + 2 * j); const f32x2 c = cs[idx];
        *(unsigned*)(kr + (size_t)tok * 64 + 2 * j) = pk2(x[0] * c[0] - x[1] * c[1], x[1] * c[0] + x[0] * c[1]); }
    const int wid = tid >> 6, lane = tid & 63;
    const int fb0 = (G >= 200) ? 192 : 0;
    for (int sid = (bx - fb0) * 8 + wid; sid < 32 && bx >= fb0; sid += G * 8) { const int b = sid >> 3, h = sid & 7; const float bias = P.fox_bias[l * 8 + h];
        float loc[32]; float run = 0.f;
#pragma unroll
        for (int i = 0; i < 32; ++i) { const int s = lane * 32 + i; const float xx = misc[(size_t)(b * 2048 + s) * 128 + 64 + h] + bias;
            const float ls = -(fmaxf(-xx, 0.f) + log1pf(expf(-fabsf(xx)))); run += ls; loc[i] = run; }
        float incl = run;
#pragma unroll
        for (int o = 1; o < 64; o <<= 1) { const float t = __shfl_up(incl, o); if (lane >= o) incl += t; }
        const float excl = incl - run; float* fc = (float*)(P.ws + WS_FC) + (size_t)sid * 2048 + lane * 32;
#pragma unroll
        for (int i = 0; i < 32; ++i) fc[i] = (loc[i] + excl) * LOG2E; }
}

#define MFMA32(a, b, c) __builtin_amdgcn_mfma_f32_32x32x16_bf16((a), (b), (c), 0, 0, 0)
__device__ __forceinline__ bf16x8 pack8(const f32x16& x, int s) {
    u32x4 p;
    if (s == 0) { p.x = pk2(x[0], x[1]); p.y = pk2(x[2], x[3]); p.z = pk2(x[4], x[5]); p.w = pk2(x[6], x[7]); }
    else { p.x = pk2(x[8], x[9]); p.y = pk2(x[10], x[11]); p.z = pk2(x[12], x[13]); p.w = pk2(x[14], x[15]); }
    return __builtin_bit_cast(bf16x8, p);
}
__device__ __forceinline__ float exp2_negabs(float x) { float r; asm("v_exp_f32 %0, -|%1|\n\ts_nop 1" : "=v"(r) : "v"(x)); return r; }
__device__ __forceinline__ void sb_sub(f32x16& s, float& carry, const int hh) {
    float w[16];
#pragma unroll
    for (int i = 0; i < 16; ++i) { const float z = s[i]; const float t = log2_(1.f + exp2_negabs(z));
        w[i] = -(__builtin_fmaxf(z, 0.f) + t); }
    const float GA = ((w[0] + w[1]) + (w[2] + w[3])) + ((w[4] + w[5]) + (w[6] + w[7])), GB = ((w[8] + w[9]) + (w[10] + w[11])) + ((w[12] + w[13]) + (w[14] + w[15]));
    const float GAp = swap_partner(GA, hh), GBp = swap_partner(GB, hh);
    float a = carry + (hh == 0 ? GBp : 0.f);
#pragma unroll
    for (int i = 15; i >= 8; --i) { const float wi = w[i]; s[i] = exp2_((s[i] + wi) + a); a += wi; }
    a = carry + GB + GBp + (hh == 0 ? GAp : 0.f);
#pragma unroll
    for (int i = 7; i >= 0; --i) { const float wi = w[i]; s[i] = exp2_((s[i] + wi) + a); a += wi; }
    carry += (GA + GB) + (GAp + GBp);
}

template <int N> __device__ __forceinline__ void at_waitv() {
    if constexpr (N == 0) asm volatile("s_waitcnt vmcnt(0)" ::: "memory");
    else if constexpr (N == 2) asm volatile("s_waitcnt vmcnt(2)" ::: "memory");
    else if constexpr (N == 3) asm volatile("s_waitcnt vmcnt(3)" ::: "memory");
    else if constexpr (N == 4) asm volatile("s_waitcnt vmcnt(4)" ::: "memory");
    else if constexpr (N == 5) asm volatile("s_waitcnt vmcnt(5)" ::: "memory");
    else static_assert(N == 0, "at_waitv: add the count");
}
#define AT_BAR() do { asm volatile("" ::: "memory"); __builtin_amdgcn_s_barrier(); asm volatile("" ::: "memory"); } while (0)
template <int TYPE  >
__device__ __forceinline__ void attn_item(const Params& P, const int b, const int h, const int qt, LAS unsigned char* lds) {
    constexpr int DQK = TYPE == 0 ? 192 : 128, KS = DQK / 16, KROWB = DQK * 2, KREG = 64 * KROWB, VREG = 16384, FREG = TYPE == 1 ? 2048 : 0, SLOT = KREG + VREG + FREG;
    constexpr int NKI = KREG / 8192, NI = NKI + 2 + (TYPE == 1 ? 1 : 0), FLAGS = 126976;
    static_assert(3 * SLOT <= FLAGS && SLOT % 256 == 0, "ring");
    const int tid = my_tid(), wid = __builtin_amdgcn_readfirstlane(tid >> 6), lane = tid & 63, l32 = lane & 31, hh = lane >> 5;
    unsigned char* ws = P.ws;
    const int bh = b * 8 + h;
    const int tq = qt * 256 + wid * 32 + l32;
    const size_t tokq = (size_t)b * 2048 + tq;
    const int NT = 4 * qt + 4, wlast = 4 * qt + (wid >> 1);
    const char* kptr[NKI]; unsigned kstr[NKI]; const char* vptr[2];
    const char* Kbase = (const char*)(ws + (TYPE == 0 ? WS_KAN : TYPE == 1 ? WS_KB : WS_KC));
#pragma unroll
    for (int i = 0; i < NKI; ++i) { const int p = (wid * NKI + i) * 64 + lane;
        if (TYPE == 0) { const int rho = p / 24, cp = p - rho * 24, c = (cp & ~7) | ((cp & 7) ^ ((rho >> 1) & 7));
            if (c < 16) { kptr[i] = Kbase + ((size_t)(b * 2048 + rho) * 1024 + h * 128) * 2 + c * 16; kstr[i] = 131072u; }
            else { kptr[i] = (const char*)(ws + WS_KR) + (size_t)(b * 2048 + rho) * 128 + (c - 16) * 16; kstr[i] = 8192u; }
        } else { const int rho = p >> 4, c = (p & 15) ^ (rho & 15); kptr[i] = Kbase + ((size_t)(b * 2048 + rho) * 1024 + h * 128) * 2 + c * 16; kstr[i] = 131072u; } }
    const char* Vbase = (const char*)(ws + (TYPE == 0 ? WS_VAT : TYPE == 1 ? WS_VBT : WS_VCT));
#pragma unroll
    for (int i = 0; i < 2; ++i) { const int p = (wid * 2 + i) * 64 + lane, r = p >> 3, c = (p & 7) ^ ((r >> 1) & 7); vptr[i] = Vbase + ((size_t)(bh * 128 + r) * 2048) * 2 + c * 16; }
    const char* fptr = (const char*)(ws + WS_FC) + ((size_t)bh * 2048 + lane) * 4;
#define AT_ISSUE(kt, so) do { \
        _Pragma("unroll") for (int i_ = 0; i_ < NKI; ++i_) __builtin_amdgcn_global_load_lds((const unsigned*)(kptr[i_] + (size_t)(kt) * kstr[i_]), (LAS unsigned*)(lds + (so) + (wid * NKI + i_) * 1024), 16, 0, 0); \
        _Pragma("unroll") for (int i_ = 0; i_ < 2; ++i_) __builtin_amdgcn_global_load_lds((const unsigned*)(vptr[i_] + (size_t)(kt) * 128), (LAS unsigned*)(lds + (so) + KREG + (wid * 2 + i_) * 1024), 16, 0, 0); \
        if (TYPE == 1) __builtin_amdgcn_global_load_lds((const unsigned*)(fptr + (size_t)(kt) * 256), (LAS unsigned*)(lds + (so) + KREG + VREG + wid * 256), 4, 0, 0); } while (0)
#define AT_TILE(it_) (TYPE == 2 ? NT - 1 - (it_) : (it_))
    float m_run = -1e30f, l_run = 0.f, carry = 0.f;
    f32x16 o0, o1, o2, o3;
#pragma unroll
    for (int i = 0; i < 16; ++i) { o0[i] = 0.f; o1[i] = 0.f; o2[i] = 0.f; o3[i] = 0.f; }
    const int pl = (l32 & ~12) | ((l32 & 4) << 1) | ((l32 & 8) >> 1);
    const unsigned a0k = (unsigned)(pl * KROWB + ((((TYPE == 0) ? ((pl >> 1) & 7) : (pl & 15)) ^ hh) << 4));
    const unsigned a0v = (unsigned)(KREG + l32 * 128 + ((((l32 >> 1) & 7) ^ hh) << 4));
    const bool ahead = false; bool have_s = false; bool wv_done = false;
    f32x16 s0, s1;
#define AT_KADDR(ks) ((TYPE == 0) ? ((kb_ ^ (unsigned)(32 * ((ks) & 3))) + (unsigned)(((ks) >> 2) * 128)) : (kb_ ^ (unsigned)(32 * (ks))))
#define AT_RK(c) do { _Pragma("unroll") for (int ks = CH * (c); ks < CH * (c) + CH; ++ks) { const unsigned ka = AT_KADDR(ks); kfa[ks] = *(const LAS bf16x8*)(lds + ka); kfb[ks] = *(const LAS bf16x8*)(lds + ka + 32 * KROWB); } } while (0)
#define AT_MK(c) do { _Pragma("unroll") for (int ks = CH * (c); ks < CH * (c) + CH; ++ks) { s0 = MFMA32(kfa[ks], qf[ks], s0); s1 = MFMA32(kfb[ks], qf[ks], s1); } } while (0)
    constexpr int CH = (KS == 12) ? 3 : 4, NC = KS / CH;
#define AT_QK(so_) do { \
        _Pragma("unroll") for (int i_ = 0; i_ < 16; ++i_) { s0[i_] = 0.f; s1[i_] = 0.f; } \
        const unsigned kb_ = a0k + (so_); bf16x8 kfa[KS], kfb[KS]; \
        AT_RK(0); \
        _Pragma("unroll") for (int c_ = 0; c_ < NC; ++c_) { if (c_ + 1 < NC) { AT_RK(c_ + 1); } __builtin_amdgcn_sched_barrier(0); AT_MK(c_); __builtin_amdgcn_sched_barrier(0); } \
          \
        asm volatile("s_nop 7\n\ts_nop 7\n\ts_nop 3" : "+v"(s0), "+v"(s1)); } while (0)
    at_waitv<0>(); AT_BAR();
    AT_ISSUE(AT_TILE(0), 0); AT_ISSUE(AT_TILE(1), SLOT);
    bf16x8 qf[KS];
    if (TYPE == 0) {
        const bf16_t* qn = (const bf16_t*)(ws + WS_QAN) + tokq * 1024 + h * 128 + hh * 8; const bf16_t* qr = (const bf16_t*)(ws + WS_QAR) + tokq * 512 + h * 64 + hh * 8;
#pragma unroll
        for (int ks = 0; ks < 8; ++ks) qf[ks] = *(const bf16x8*)(qn + ks * 16);
#pragma unroll
        for (int ks = 8; ks < KS; ++ks) qf[ks] = *(const bf16x8*)(qr + (ks - 8) * 16);
    } else {
        const bf16_t* qp = (const bf16_t*)(ws + (TYPE == 1 ? WS_QB : WS_QC)) + tokq * 1024 + h * 128 + hh * 8;
#pragma unroll
        for (int ks = 0; ks < KS; ++ks) qf[ks] = *(const bf16x8*)(qp + ks * 16);
    }
#pragma unroll
    for (int ks = 0; ks < KS; ++ks) asm volatile("" : "+v"(qf[ks]));
    unsigned so = 0, so2 = 2 * SLOT;
    for (int it = 0; it < NT; ++it) {
        const int kt = AT_TILE(it);
        if (it + 1 < NT) at_waitv<NI>(); else at_waitv<0>();
        AT_BAR();
        if (TYPE == 2 && it > 0) { const LAS int* fl = (const LAS int*)(lds + FLAGS + ((it - 1) & 1) * 32);
            if (fl[0] & fl[1] & fl[2] & fl[3] & fl[4] & fl[5] & fl[6] & fl[7]) break; }
        if (it + 2 < NT) AT_ISSUE(AT_TILE(it + 2), so2);
        if (kt <= wlast && !(TYPE == 2 && wv_done)) {
            if (!have_s) { AT_QK(so); }
            const unsigned vb = a0v + so;
            bf16x8 vf0[4], vf1[4], vf2[4], vf3[4];
#define AT_RV(vf, mb) do { vf[0] = *(const LAS bf16x8*)(lds + vb + (mb) * 4096); vf[1] = *(const LAS bf16x8*)(lds + (vb ^ 32u) + (mb) * 4096); \
                vf[2] = *(const LAS bf16x8*)(lds + (vb ^ 64u) + (mb) * 4096); vf[3] = *(const LAS bf16x8*)(lds + (vb ^ 96u) + (mb) * 4096); } while (0)
            AT_RV(vf0, 0);
            __builtin_amdgcn_sched_barrier(0);
            const bool diag = (kt == wlast);
            const int key0 = kt * 64 + 8 * hh;
            if (TYPE == 2) {
                if (diag) {
#pragma unroll
                    for (int i = 0; i < 16; ++i) { const int key = key0 + 16 * (i >> 3) + (i & 7); if (key >= tq) s0[i] = -1e30f; if (key + 32 >= tq) s1[i] = -1e30f; } }
                sb_sub(s1, carry, hh); sb_sub(s0, carry, hh);
            } else {
                if (TYPE == 1) { const LAS float* fb = (const LAS float*)(lds + so + KREG + VREG + wid * 256) + 8 * hh;
#pragma unroll
                    for (int j = 0; j < 8; ++j) {
                        const f32x2 b0 = *(const LAS f32x2*)(fb + 16 * (j >> 2) + 2 * (j & 3)), b1 = *(const LAS f32x2*)(fb + 32 + 16 * (j >> 2) + 2 * (j & 3));
                        const f32x2 x0 = pk_sub((f32x2){s0[2 * j], s0[2 * j + 1]}, b0), x1 = pk_sub((f32x2){s1[2 * j], s1[2 * j + 1]}, b1);
                        s0[2 * j] = x0[0]; s0[2 * j + 1] = x0[1]; s1[2 * j] = x1[0]; s1[2 * j + 1] = x1[1]; }
                    if (diag) {
#pragma unroll
                        for (int i = 0; i < 16; ++i) { const int key = key0 + 16 * (i >> 3) + (i & 7); if (key > tq) s0[i] = -1e30f; if (key + 32 > tq) s1[i] = -1e30f; } } }
                float mx = m_run;
#pragma unroll
                for (int i = 0; i < 16; ++i) mx = max3_(mx, s0[i], s1[i]);
                asm volatile("s_nop 1" : "+v"(mx));
                const float mnew = swap_max(mx);
                const f32x2 mm = {mnew, mnew}; f32x2 rs2 = {0.f, 0.f};
#pragma unroll
                for (int j = 0; j < 8; ++j) { const f32x2 x0 = pk_sub((f32x2){s0[2 * j], s0[2 * j + 1]}, mm), x1 = pk_sub((f32x2){s1[2 * j], s1[2 * j + 1]}, mm);
                    s0[2 * j] = exp2_(x0[0]); s0[2 * j + 1] = exp2_(x0[1]); s1[2 * j] = exp2_(x1[0]); s1[2 * j + 1] = exp2_(x1[1]);
                    rs2 += (f32x2){s0[2 * j], s0[2 * j + 1]} + (f32x2){s1[2 * j], s1[2 * j + 1]}; }
                const float rs = rs2[0] + rs2[1];
                if (__any(mnew > m_run)) {
                    const float alpha = exp2_(m_run - mnew);
                    l_run *= alpha; o0 *= alpha; o1 *= alpha; o2 *= alpha; o3 *= alpha;
                }
                l_run += rs; m_run = mnew;
            }
            const bf16x8 p00 = pack8(s0, 0), p01 = pack8(s0, 1), p10 = pack8(s1, 0), p11 = pack8(s1, 1);
#define AT_PV(o, vf) do { o = MFMA32(vf[0], p00, o); o = MFMA32(vf[1], p01, o); o = MFMA32(vf[2], p10, o); o = MFMA32(vf[3], p11, o); } while (0)
            __builtin_amdgcn_sched_barrier(0);
            AT_RV(vf1, 1); AT_PV(o0, vf0); __builtin_amdgcn_sched_barrier(0);
            AT_RV(vf2, 2); AT_PV(o1, vf1); __builtin_amdgcn_sched_barrier(0);
            AT_RV(vf3, 3); AT_PV(o2, vf2); __builtin_amdgcn_sched_barrier(0);
            AT_PV(o3, vf3); __builtin_amdgcn_sched_barrier(0);
#undef AT_PV
#undef AT_RV
        }
        if (TYPE == 2) { wv_done = wv_done || ((kt <= wlast) && __all(carry < -140.f)); if (lane == 0) *(LAS int*)(lds + FLAGS + (it & 1) * 32 + wid * 4) = wv_done ? 1 : 0; }
        so = (so == 2 * SLOT) ? 0u : so + SLOT; so2 = (so2 == 2 * SLOT) ? 0u : so2 + SLOT;
        have_s = false;
        if (ahead && it + 1 < NT && AT_TILE(it + 1) <= wlast) { AT_QK(so); have_s = true; }
    }
#undef AT_ISSUE
#undef AT_TILE
#undef AT_QK
#undef AT_RK
#undef AT_MK
#undef AT_KADDR
    float inv = 1.f;
    if (TYPE != 2) inv = 1.f / swap_sum(l_run);
    at_waitv<0>(); AT_BAR();
    {
        const unsigned ob = (unsigned)(wid * 8704 + l32 * 272 + 8 * hh);
#define AT_OUT(o, mb) do { _Pragma("unroll") for (int g = 0; g < 4; ++g) { u32x2 w; w.x = pk2(o[4 * g] * inv, o[4 * g + 1] * inv); w.y = pk2(o[4 * g + 2] * inv, o[4 * g + 3] * inv); \
            *(LAS u32x2*)(lds + ob + (mb) * 64 + g * 16) = w; } } while (0)
        AT_OUT(o0, 0); AT_OUT(o1, 1); AT_OUT(o2, 2); AT_OUT(o3, 3);
#undef AT_OUT
        const size_t tok0 = (size_t)b * 2048 + qt * 256 + wid * 32;
        const bf16_t* sg = (const bf16_t*)(ws + WS_SG) + (size_t)TYPE * T * 1024 + tok0 * 1024 + h * 128;
        bf16_t* ys = (bf16_t*)(ws + WS_YS) + (size_t)TYPE * T * 1024 + tok0 * 1024 + h * 128;
        u32x4 gv[8];
#pragma unroll
        for (int i = 0; i < 8; ++i) { const int c = lane + 64 * i, r = c >> 4, cc = c & 15; gv[i] = *(const u32x4*)(sg + (size_t)r * 1024 + cc * 8); }
#pragma unroll
        for (int i = 0; i < 8; ++i) { const int c = lane + 64 * i, r = c >> 4, cc = c & 15;
            const u32x4 ov = *(const LAS u32x4*)(lds + wid * 8704 + r * 272 + cc * 16); u32x4 w;
            w.x = pk2(__uint_as_float(ov.x << 16) * __uint_as_float(gv[i].x << 16), __uint_as_float(ov.x & 0xffff0000u) * __uint_as_float(gv[i].x & 0xffff0000u));
            w.y = pk2(__uint_as_float(ov.y << 16) * __uint_as_float(gv[i].y << 16), __uint_as_float(ov.y & 0xffff0000u) * __uint_as_float(gv[i].y & 0xffff0000u));
            w.z = pk2(__uint_as_float(ov.z << 16) * __uint_as_float(gv[i].z << 16), __uint_as_float(ov.z & 0xffff0000u) * __uint_as_float(gv[i].z & 0xffff0000u));
            w.w = pk2(__uint_as_float(ov.w << 16) * __uint_as_float(gv[i].w << 16), __uint_as_float(ov.w & 0xffff0000u) * __uint_as_float(gv[i].w & 0xffff0000u));
            *(u32x4*)(ys + (size_t)r * 1024 + cc * 8) = w; }
    }
}

__device__ __forceinline__ void attn_run(const Params& P, int type, int bh, int qt, LAS unsigned char* lds) {
    const int b = bh >> 3, h = bh & 7;
#ifndef ATT_MASK
#define ATT_MASK 7
#endif
    if ((ATT_MASK & 1) && type == 0) attn_item<0>(P, b, h, qt, lds); else if ((ATT_MASK & 2) && type == 1) attn_item<1>(P, b, h, qt, lds); else if ((ATT_MASK & 4) && type == 2) attn_item<2>(P, b, h, qt, lds);
}
__device__ __forceinline__ void phase_attn(const Params& P, LAS unsigned char* lds) {
    const int G = my_G(), c = my_bx();
    if (G == 256) {
        const int x = c & 7, j = c >> 3, bh = 4 * x + (j >> 3), k = j & 7;
#pragma unroll 1
        for (int r = 0; r < 3; ++r) attn_run(P, r, bh, r == 0 ? k : 7 - k, lds);
    } else {
#pragma unroll 1
        for (int idx = c; idx < 768; idx += G) { const int qt = 7 - idx / 96, r = idx % 96; attn_run(P, r >> 5, r & 31, qt, lds); }
    }
    asm volatile("s_waitcnt vmcnt(0)" ::: "memory"); __syncthreads();
}

#define XB_TMO      128
#define XB_XCNT(j)  (256  + 64 * (j))
#define XB_XSUB(j)  (1280 + 64 * (j))
#define XB_XGEN(j)  (2304 + 64 * (j))
#define XB_TOP      3328
#define XB_TOPGEN   3392
#define XCD_BAR_WORDS 3456
#define XB_SPIN_CAP (1u << 18)
__device__ __forceinline__ unsigned xb_ld(unsigned* p)              { return __hip_atomic_load(p, __ATOMIC_RELAXED, __HIP_MEMORY_SCOPE_AGENT); }
__device__ __forceinline__ unsigned xb_add(unsigned* p, unsigned v) { return __hip_atomic_fetch_add(p, v, __ATOMIC_RELAXED, __HIP_MEMORY_SCOPE_AGENT); }
__device__ __forceinline__ unsigned xb_xcc_id() { return (unsigned)__builtin_amdgcn_s_getreg((3 << 11) | 20) & 0xFu; }
#define XB_SPIN(cond, bar) do { unsigned _sp = 0; while (cond) { __builtin_amdgcn_s_sleep(1); \
    if ((++_sp & 255u) == 0u) { if (xb_ld(&(bar)[XB_TMO])) break; if (_sp > XB_SPIN_CAP) { atomicAdd(&(bar)[XB_TMO], 1u); break; } } } } while (0)
struct XcdBarrier { unsigned* bar; unsigned x; volatile LAS unsigned* st; };
__device__ __forceinline__ XcdBarrier xcd_barrier_post(unsigned* bar, volatile LAS unsigned* st) {
    XcdBarrier b; b.bar = bar; b.x = xb_xcc_id(); b.st = st;
    if (threadIdx.x == 0) (void)xb_add(&bar[XB_XCNT(b.x)], 1u);
    return b;
}
__device__ __forceinline__ void xcd_barrier_complete(unsigned* bar, unsigned x, unsigned& nloc, unsigned& nx) {
    const unsigned G = gridDim.x * gridDim.y * gridDim.z;
    unsigned sum, cnt, mine, sp = 0u;
    for (;;) {
        sum = 0u; cnt = 0u; mine = 0u;
#pragma unroll
        for (unsigned j = 0; j < 16; ++j) { const unsigned c = xb_ld(&bar[XB_XCNT(j)]); sum += c; cnt += (c > 0u) ? 1u : 0u; mine = (j == x) ? c : mine; }
        if (sum == G) break;
        __builtin_amdgcn_s_sleep(1);
        if ((++sp & 255u) == 0u) { if (xb_ld(&bar[XB_TMO])) break; if (sp > XB_SPIN_CAP) { atomicAdd(&bar[XB_TMO], 1u); break; } }
    }
    nloc = mine > 0u ? mine : 1u; nx = cnt > 0u ? cnt : 1u;
}
__device__ __forceinline__ void xcd_barrier(const XcdBarrier& b) {
    asm volatile("s_waitcnt vmcnt(0)" ::: "memory");
    __syncthreads();
    if (threadIdx.x == 0) {
        unsigned* bar = b.bar;
        __builtin_amdgcn_s_waitcnt(0);
        unsigned nloc = b.st[0], nx = b.st[1];
        if (nloc == 0u) { xcd_barrier_complete(bar, b.x, nloc, nx); b.st[0] = nloc; b.st[1] = nx; }
        const unsigned old = xb_add(&bar[XB_XSUB(b.x)], 1u);
        const unsigned gen = old / nloc;
        if (old + 1u == (gen + 1u) * nloc) {
            __builtin_amdgcn_fence(__ATOMIC_RELEASE, "agent");
            asm volatile("s_waitcnt vmcnt(0)" ::: "memory");
            const unsigned og = xb_add(&bar[XB_TOP], 1u);
            const unsigned tg = og / nx;
            if (og + 1u == (tg + 1u) * nx) xb_add(&bar[XB_TOPGEN], 1u);
            else XB_SPIN(xb_ld(&bar[XB_TOPGEN]) == tg, bar);
            __builtin_amdgcn_fence(__ATOMIC_ACQUIRE, "agent");
            xb_add(&bar[XB_XGEN(b.x)], 1u);
            asm volatile("s_waitcnt vmcnt(0)" ::: "memory");
        } else {
            XB_SPIN(xb_ld(&bar[XB_XGEN(b.x)]) == gen, bar);
            __builtin_amdgcn_fence(__ATOMIC_ACQUIRE, "agent");
            asm volatile("s_waitcnt vmcnt(0)" ::: "memory");
        }
    }
    __syncthreads();
}

constexpr int N_PHASES = 2 + 6 * NLAYER;
__global__ void __launch_bounds__(512, 2) mega(Params P0) {
    extern __shared__ __attribute__((aligned(16))) unsigned char smem[];
    LAS unsigned char* lds = (LAS unsigned char*)smem;
    cg::grid_group grid = cg::this_grid();
    const int lo = P0.ph_lo, hi = P0.ph_hi;
    volatile LAS unsigned* xst = (volatile LAS unsigned*)(lds + 131072 + 16);
    if (threadIdx.x == 0) { xst[0] = 0u; xst[1] = 0u; }
    __syncthreads();
    const XcdBarrier xbar = xcd_barrier_post((unsigned*)(P0.ws + WS_BAR), xst);
#ifndef PH_MASK
#define PH_MASK 0xff
#endif
#ifndef DUP_MASK
#define DUP_MASK 0
#endif
#ifndef EXTRA_SYNC
#define EXTRA_SYNC 0
#endif
#define NDUP(bit) ((DUP_MASK & (bit)) ? 2 : 1)
#define IN(k) (lo <= (k) && (k) < hi)
#define SEAM(k) do { if (IN(k) && IN((k) + 1)) { if ((k) == 0) grid.sync(); else xcd_barrier(xbar); if (EXTRA_SYNC) xcd_barrier(xbar); } } while (0)
#define FRESH() Params P = P0; { unsigned char* w_ = P0.ws; asm volatile("" : "+s"(w_)); P.ws = w_; } unsigned char* ws = P.ws; (void)ws; const int G = my_G(), bx = my_bx(); (void)G; (void)bx
    if ((PH_MASK & 1) && IN(0)) { for (int d = 0; d < NDUP(1); ++d) { FRESH(); phase_prologue(P, lds, d); if (d + 1 < NDUP(1)) grid.sync(); } SEAM(0); }
#pragma unroll 1
    for (int l = 0; l < NLAYER; ++l) {
        const int p0 = 1 + 6 * l;
        if ((PH_MASK & 2) && IN(p0)) { FRESH(); phase_ln(P, l); SEAM(p0); }
        if ((PH_MASK & 4) && IN(p0 + 1)) {
            FRESH(); unsigned char* wl = ws + WS_W + (size_t)l * SZ_WL;
            __syncthreads();
            pg8::Gemm g{(const bf16_t*)(ws + WS_U), (const bf16_t*)wl, T, N1, DM}; pg8::StaticOrder S; S.init(T, N1, G, bx);
            Epi1 E{ws};
            for (int d = 0; d < NDUP(4); ++d) { pg8::gemm_phase<Epi1, pg8::StaticOrder, true, true>(lds, g, S, E); if (d + 1 < NDUP(4)) grid.sync(); }
            SEAM(p0 + 1);
        }
        if ((PH_MASK & 8) && IN(p0 + 2)) {
            { FRESH(); phase_small(P, l); }
            __syncthreads();
            { FRESH(); unsigned char* wl = ws + WS_W + (size_t)l * SZ_WL;
              pg8::Gemm g{(const bf16_t*)(ws + WS_CQ), (const bf16_t*)(wl + OFF_BT2Q), T, 1536, 512}; pg8::StaticOrder S; S.init(T, 1536, G, bx);
              Epi2<0> E{ws}; pg8::gemm_phase<Epi2<0>, pg8::StaticOrder, false, true>(lds, g, S, E); }
            __syncthreads();
            { FRESH(); unsigned char* wl = ws + WS_W + (size_t)l * SZ_WL;
              pg8::Gemm g{(const bf16_t*)(ws + WS_CKV), (const bf16_t*)(wl + OFF_BT2KV), T, 2048, 256}; pg8::StaticOrder S; S.init(T, 2048, G, bx);
              Epi2<1> E{ws}; pg8::gemm_phase<Epi2<1>, pg8::StaticOrder, false, true>(lds, g, S, E); }
            SEAM(p0 + 2);
        }
        if ((PH_MASK & 16) && IN(p0 + 3)) { for (int d = 0; d < NDUP(16); ++d) { FRESH(); phase_attn(P, lds); if (d + 1 < NDUP(16)) grid.sync(); } SEAM(p0 + 3); }
        if ((PH_MASK & 32) && IN(p0 + 4)) {
            FRESH(); unsigned char* wl = ws + WS_W + (size_t)l * SZ_WL;
            __syncthreads();
            pg8::Gemm g{(const bf16_t*)(ws + WS_YS), (const bf16_t*)(wl + OFF_BT3), 3 * T, 3 * 2048, 1024}; pg8::BranchOrder S; S.so.init(T, 2048, G, bx);
            Epi3 E{ws};
            pg8::gemm_phase<Epi3, pg8::BranchOrder, true, true>(lds, g, S, E);
            SEAM(p0 + 4);
        }
        if ((PH_MASK & 64) && IN(p0 + 5)) {
            FRESH(); unsigned char* wl = ws + WS_W + (size_t)l * SZ_WL;
            __syncthreads();
            pg8::Gemm g{(const bf16_t*)(ws + WS_MRG), (const bf16_t*)(wl + OFF_BT4), T, 2048, 2048}; pg8::StaticOrder S; S.init(T, 2048, G, bx);
            Epi4 E{(bf16_t*)(ws + WS_MRG2)};
            pg8::gemm_phase<Epi4, pg8::StaticOrder, false, true>(lds, g, S, E);
            SEAM(p0 + 5);
        }
    }
    if ((PH_MASK & 2) && IN(N_PHASES - 1)) { FRESH(); phase_ln(P, 4); }
#undef IN
#undef SEAM
#undef FRESH
}

extern "C" void kernel_launch(void* const* d_in, const int* in_sizes, int n_in, void* d_out, int out_size, void* d_ws, size_t ws_size, hipStream_t stream) {
    static int grid = 0;
    if (grid == 0) {
        if (n_in != 15 || ws_size < WS_END) { fprintf(stderr, "kernel_launch: bad inputs (n_in %d, ws %zu < %zu)\n", n_in, ws_size, (size_t)WS_END); grid = -1; return; }
        int dev = 0, cus = 0, per_cu = 0;
        hipGetDevice(&dev); hipDeviceGetAttribute(&cus, hipDeviceAttributeMultiprocessorCount, dev);
        if (hipFuncSetAttribute((const void*)mega, hipFuncAttributeMaxDynamicSharedMemorySize, LDS_BYTES) != hipSuccess) { fprintf(stderr, "kernel_launch: hipFuncSetAttribute failed\n"); grid = -1; return; }
        if (hipOccupancyMaxActiveBlocksPerMultiprocessor(&per_cu, (const void*)mega, 512, LDS_BYTES) != hipSuccess || per_cu < 1) { fprintf(stderr, "kernel_launch: occupancy query says %d\n", per_cu); per_cu = 1; }
        (void)hipGetLastError();
        grid = cus * per_cu;
    }
    if (grid < 0) return;
    (void)hipMemsetAsync((char*)d_ws + WS_CTR, 0, WS_ZERO_BYTES, stream);
    Params p{};
    p.x = (const float*)d_in[0]; p.c = (const float*)d_in[1]; p.pos = (const int*)d_in[2]; p.w_ada = (const float*)d_in[3]; p.b_ada = (const float*)d_in[4]; p.w_in = (const float*)d_in[5];
    p.qng = (const float*)d_in[6]; p.kvng = (const float*)d_in[7]; p.w_uq = (const float*)d_in[8]; p.w_ukv = (const float*)d_in[9]; p.fox_bias = (const float*)d_in[10];
    p.w_branch = (const float*)d_in[11]; p.w_out = (const float*)d_in[12]; p.ln_g = (const float*)d_in[13]; p.ln_b = (const float*)d_in[14];
    p.out = (float*)d_out; p.ws = (unsigned char*)d_ws;
#if PER_PHASE_LAUNCH
    for (int ph = 0; ph < N_PHASES; ++ph) { p.ph_lo = ph; p.ph_hi = ph + 1; hipLaunchKernelGGL(mega, dim3(grid), dim3(512), LDS_BYTES, stream, p); }
#else
    p.ph_lo = 0; p.ph_hi = N_PHASES;
    void* args[] = {&p};
    hipError_t e = hipLaunchCooperativeKernel((const void*)mega, dim3(grid), dim3(512), args, LDS_BYTES, stream);
    if (e != hipSuccess) fprintf(stderr, "kernel_launch: cooperative launch failed: %s (grid %d)\n", hipGetErrorString(e), grid);
#endif
}
```

```cpp
#include <hip/hip_runtime.h>
#include <hip/hip_cooperative_groups.h>
#include <cstdio>
#include <cstdint>
#include <cmath>
namespace cg = cooperative_groups;

#ifndef PER_PHASE_LAUNCH
#define PER_PHASE_LAUNCH 0
#endif

#define LAS __attribute__((address_space(3)))
typedef unsigned short bf16_t;
typedef short bf16x8 __attribute__((ext_vector_type(8)));
typedef float f32x4 __attribute__((ext_vector_type(4)));
typedef float f32x2 __attribute__((ext_vector_type(2)));
typedef float f32x16 __attribute__((ext_vector_type(16)));
typedef unsigned u32x4 __attribute__((ext_vector_type(4)));
typedef unsigned u32x2 __attribute__((ext_vector_type(2)));
typedef __bf16 bf16x2_t __attribute__((ext_vector_type(2)));

constexpr int T = 8192, DM = 2048, SEQ = 2048, NBATCH = 4, NLAYER = 4, DIN = 16200, N1 = 16384;
constexpr float LOG2E = 1.4426950408889634f;
constexpr float ALPHA = 1.681792830507429f;
constexpr int LDS_BYTES = 131072 + 1024;

constexpr size_t al256(size_t x) { return (x + 255) & ~(size_t)255; }
constexpr size_t SZ_BT1 = (size_t)N1 * DM * 2, SZ_BT2Q = (size_t)1536 * 512 * 2, SZ_BT2KV = (size_t)2048 * 256 * 2, SZ_BT3 = (size_t)3 * 2048 * 1024 * 2, SZ_BT4 = (size_t)2048 * 2048 * 2;
constexpr size_t OFF_BT2Q = SZ_BT1, OFF_BT2KV = OFF_BT2Q + SZ_BT2Q, OFF_BT3 = OFF_BT2KV + SZ_BT2KV, OFF_BT4 = OFF_BT3 + SZ_BT3, SZ_WL = OFF_BT4 + SZ_BT4;
constexpr size_t WS_CTR = 0;
constexpr size_t WS_BAR = 256;
constexpr size_t WS_ZERO_BYTES = 256 + 16384;
constexpr size_t WS_W = WS_ZERO_BYTES;
constexpr size_t WS_MOD = al256(WS_W + NLAYER * SZ_WL);
constexpr size_t WS_CS = al256(WS_MOD + (size_t)NLAYER * 4 * 6144 * 4);
constexpr size_t WS_U = al256(WS_CS + (size_t)T * 32 * 8);
constexpr size_t WS_X = al256(WS_U + (size_t)T * DM * 2);
constexpr size_t WS_Y = al256(WS_X + (size_t)T * DM * 4);
constexpr size_t WS_MRG2 = WS_Y;
constexpr size_t WS_CQ = al256(WS_Y + (size_t)T * DM * 4);
constexpr size_t WS_CKV = al256(WS_CQ + (size_t)T * 512 * 2);
constexpr size_t WS_SSQ = al256(WS_CKV + (size_t)T * 256 * 2);
constexpr size_t WS_SG = al256(WS_SSQ + (size_t)T * 16 * 4);
constexpr size_t SZ_TH = (size_t)T * 1024 * 2;
constexpr size_t WS_QB = al256(WS_SG + 3 * SZ_TH), WS_KB = WS_QB + SZ_TH, WS_VBT = WS_KB + SZ_TH, WS_QC = WS_VBT + SZ_TH, WS_KC = WS_QC + SZ_TH, WS_VCT = WS_KC + SZ_TH;
constexpr size_t WS_QAN = WS_VCT + SZ_TH, WS_KAN = WS_QAN + SZ_TH, WS_VAT = WS_KAN + SZ_TH;
constexpr size_t WS_QAR = WS_VAT + SZ_TH;
constexpr size_t WS_KR = al256(WS_QAR + (size_t)T * 512 * 2);
constexpr size_t WS_MISC = al256(WS_KR + (size_t)T * 64 * 2);
constexpr size_t WS_FC = al256(WS_MISC + (size_t)T * 128 * 4);
constexpr size_t WS_MG = al256(WS_FC + (size_t)32 * 2048 * 4);
constexpr size_t WS_YS = al256(WS_MG + (size_t)T * 6144 * 2);
constexpr size_t WS_MACC = al256(WS_YS + 3 * SZ_TH);
constexpr size_t WS_MRG = al256(WS_MACC + (size_t)T * DM * 4);
constexpr size_t WS_END = al256(WS_MRG + (size_t)T * DM * 2);

struct Params {
    const float* x; const float* c; const int* pos; const float* w_ada; const float* b_ada; const float* w_in;
    const float* qng; const float* kvng; const float* w_uq; const float* w_ukv; const float* fox_bias;
    const float* w_branch; const float* w_out; const float* ln_g; const float* ln_b;
    float* out; unsigned char* ws;
    int ph_lo, ph_hi;
};

__device__ __forceinline__ unsigned pk2(float lo, float hi) { f32x2 v = {lo, hi}; bf16x2_t b = __builtin_convertvector(v, bf16x2_t); return __builtin_bit_cast(unsigned, b); }
__device__ __forceinline__ bf16_t f2bf(float x) { return (bf16_t)(pk2(x, 0.f) & 0xffffu); }
__device__ __forceinline__ float bf2f(bf16_t b) { return __uint_as_float(((unsigned)b) << 16); }
__device__ __forceinline__ float wave_sum(float v) {
#pragma unroll
    for (int o = 32; o >= 1; o >>= 1) v += __shfl_xor(v, o);
    return v;
}
__device__ __forceinline__ float sigmoidf_(float x) { return __builtin_amdgcn_rcpf(1.f + __expf(-x)); }
__device__ __forceinline__ float siluf_(float x) { return x * sigmoidf_(x); }
__device__ __forceinline__ float exp2_(float x) { return __builtin_amdgcn_exp2f(x); }
__device__ __forceinline__ float log2_(float x) { return __builtin_amdgcn_logf(x); }
__device__ __forceinline__ float max3_(float a, float b, float c) { float r; asm("v_max3_f32 %0, %1, %2, %3" : "=v"(r) : "v"(a), "v"(b), "v"(c)); return r; }
__device__ __forceinline__ f32x2 pk_sub(f32x2 a, f32x2 b) { f32x2 r; asm("v_pk_add_f32 %0, %1, %2 neg_lo:[0,1] neg_hi:[0,1]" : "=v"(r) : "v"(a), "v"(b)); return r; }
__device__ __forceinline__ f32x2 pk_add(f32x2 a, f32x2 b) { f32x2 r; asm("v_pk_add_f32 %0, %1, %2" : "=v"(r) : "v"(a), "v"(b)); return r; }
__device__ __forceinline__ float swap_max(float x) { auto rr = __builtin_amdgcn_permlane32_swap(__float_as_uint(x), __float_as_uint(x), false, false); return fmaxf(__uint_as_float(rr[0]), __uint_as_float(rr[1])); }
__device__ __forceinline__ float swap_sum(float x) { auto rr = __builtin_amdgcn_permlane32_swap(__float_as_uint(x), __float_as_uint(x), false, false); return __uint_as_float(rr[0]) + __uint_as_float(rr[1]); }
__device__ __forceinline__ float swap_partner(float x, int hh) { auto rr = __builtin_amdgcn_permlane32_swap(__float_as_uint(x), __float_as_uint(x), false, false); return __uint_as_float(hh ? rr[0] : rr[1]); }

__device__ __forceinline__ int my_tid() { int t = threadIdx.x; asm volatile("" : "+v"(t)); return t; }
__device__ __forceinline__ int my_bx() { int b = blockIdx.x; asm volatile("" : "+s"(b)); return b; }
__device__ __forceinline__ int my_G() { int g = gridDim.x; asm volatile("" : "+s"(g)); return g; }
namespace pg8 {
#define PG8_LAS __attribute__((address_space(3)))
constexpr int BM = 256, BK = 64, HALF = 128, HTB = HALF * BK * 2, STAGE_BYTES = 8 * HTB, NXCD = 8, WGM = 8;
__host__ __device__ __forceinline__ int lds_byte(int r, int c) { const int st = (r >> 4) * 2 + (c >> 5), rr = r & 15, cc = c & 31, ob = rr * 64 + cc * 2; return st * 1024 + (ob ^ (((ob >> 9) & 1) << 5)); }
__host__ __device__ __forceinline__ void stage_rc(int b, int& R, int& C) { const int st = b / 1024, sb = b % 1024, swz = sb ^ (((sb >> 9) & 1) << 5); R = (st >> 1) * 16 + swz / 64; C = (st & 1) * 32 + (swz % 64) / 2; }
__host__ __device__ __forceinline__ int perm32(int rho) { const int n = rho >> 4, i = rho & 15; return 8 * (i >> 2) + 4 * n + (i & 3); }
struct Unit { int pm, pn; };
struct Gemm { const bf16_t* A; const bf16_t* Bt; int M, N, K; };
struct StaticOrder {
    int nM, nN, nwg, G, c;
    __host__ __device__ void init(int M, int N, int G_, int c_) { nM = M / BM; nN = N / BM; nwg = nM * nN; G = G_; c = c_; }
    __host__ __device__ bool next(int i, Unit& u) const {
        const long L = (long)i * G + c; if (L >= nwg) return false;
        int wgid = (int)L; { const int q = nwg / NXCD, r = nwg % NXCD, xcd = wgid % NXCD, off = wgid / NXCD; wgid = (xcd < r ? xcd * (q + 1) : r * (q + 1) + (xcd - r) * q) + off; }
        const int nig = WGM * nN, gid = wgid / nig, fm = gid * WGM, gsz = (nM - fm) < WGM ? (nM - fm) : WGM;
        u.pm = fm + ((wgid % nig) % gsz); u.pn = (wgid % nig) / gsz; return true;
    }
    __device__ __forceinline__ void a_ready(const Unit&) const {}
    __device__ __forceinline__ void done(const Unit&) const {}
};
struct BranchOrder {
    StaticOrder so;
    __device__ bool next(int i, Unit& u) const { Unit t; if (!so.next(i / 3, t)) return false; const int n = i % 3; u.pm = n * 32 + t.pm; u.pn = n * 8 + t.pn; return true; }
    __device__ __forceinline__ void a_ready(const Unit&) const {}
    __device__ __forceinline__ void done(const Unit&) const {}
};

template <class Epi, class Sched, bool ALIGN_EPI = false, bool SP2 = false>
__device__ __forceinline__ void gemm_phase(PG8_LAS unsigned char* lds, const Gemm g, const Sched& S, const Epi& E) {
    const int tid = my_tid(), wid = __builtin_amdgcn_readfirstlane(tid >> 6), lane = tid & 63, wr = wid >> 2, wc = wid & 3, fr = lane & 15, fq = lane >> 4;
    const int K = g.K, nt = K / BK;
    unsigned voffA[2], voffB[2];
#pragma unroll
    for (int i = 0; i < 2; ++i) { int R, C; stage_rc(tid * 16 + i * 8192, R, C); const int Rb = Epi::PERM ? ((R & ~31) + perm32(R & 31)) : R;
        voffA[i] = (unsigned)(R * K + C) * 2u; voffB[i] = (unsigned)(Rb * K + C) * 2u; }
    const size_t kstep = (size_t)(BK * 2);
    const size_t hstep = (size_t)HALF * K * 2;
    const size_t tstep = 2 * hstep;
    const unsigned ldsw = (unsigned)wid * 1024u;
    const int aoff = lds_byte(wr * 64 + fr, fq * 8), boff = lds_byte(wc * 32 + fr, fq * 8);
#define PG8_SA(b, h) (((b) * 2 + (h)) * HTB)
#define PG8_SB(b, h) ((4 + (b) * 2 + (h)) * HTB)
#define PG8_STAGE(bufoff, gbase, voff) do { _Pragma("unroll") for (int _i = 0; _i < 2; ++_i) \
        __builtin_amdgcn_global_load_lds((const unsigned*)((const char*)(gbase) + (voff)[_i]), (PG8_LAS unsigned*)(lds + (bufoff) + ldsw + _i * 8192), 16, 0, 0); } while (0)
#define PG8_LDA(dst, b, h) do { _Pragma("unroll") for (int m = 0; m < 4; ++m) _Pragma("unroll") for (int k = 0; k < 2; ++k) dst[m][k] = *(const PG8_LAS bf16x8*)(lds + PG8_SA(b, h) + aoff + m * 2048 + k * 1024); } while (0)
#define PG8_LDB(dst, b, h) do { _Pragma("unroll") for (int n = 0; n < 2; ++n) _Pragma("unroll") for (int k = 0; k < 2; ++k) dst[n][k] = *(const PG8_LAS bf16x8*)(lds + PG8_SB(b, h) + boff + n * 2048 + k * 1024); } while (0)
#define PG8_MMA(ai, bj, At, Bt) do { __builtin_amdgcn_s_setprio(1); _Pragma("unroll") for (int m = 0; m < 4; ++m) _Pragma("unroll") for (int n = 0; n < 2; ++n) _Pragma("unroll") for (int k = 0; k < 2; ++k) \
        acc[ai][bj][m][n] = __builtin_amdgcn_mfma_f32_16x16x32_bf16(Bt[n][k], At[m][k], acc[ai][bj][m][n], 0, 0, 0); __builtin_amdgcn_s_setprio(0); } while (0)
#define PG8_WAIT_V(n) asm volatile("s_waitcnt vmcnt(" #n ")" ::: "memory")
#define PG8_WAIT_L(n) asm volatile("s_waitcnt lgkmcnt(" #n ")" ::: "memory")
#define PG8_BAR __builtin_amdgcn_s_barrier()
#define PG8_SCHED __builtin_amdgcn_sched_barrier(0)
    Unit cur, nxt; int ui = 0;
    if (!S.next(0, cur)) return;
    f32x4 acc[2][2][4][2];
#pragma unroll
    for (int a = 0; a < 2; ++a)
#pragma unroll
        for (int b = 0; b < 2; ++b)
#pragma unroll
            for (int m = 0; m < 4; ++m)
#pragma unroll
                for (int n = 0; n < 2; ++n) acc[a][b][m][n] = (f32x4){0.f, 0.f, 0.f, 0.f};
    bf16x8 At[4][2], B0[2][2], B1[2][2];
    const char* cA = (const char*)g.A + (size_t)cur.pm * tstep; const char* cB = (const char*)g.Bt + (size_t)cur.pn * tstep;
    S.a_ready(cur);
    if constexpr (SP2) {
        PG8_STAGE(PG8_SB(0, 0), cB, voffB); PG8_STAGE(PG8_SB(0, 1), cB + hstep, voffB); PG8_STAGE(PG8_SA(0, 0), cA, voffA); PG8_STAGE(PG8_SA(0, 1), cA + hstep, voffA);
        if (wr == 1) PG8_BAR;
        PG8_WAIT_V(2); PG8_BAR;
        PG8_STAGE(PG8_SB(1, 0), cB + kstep, voffB); PG8_STAGE(PG8_SA(1, 0), cA + kstep, voffA); PG8_STAGE(PG8_SB(1, 1), cB + hstep + kstep, voffB);
        PG8_WAIT_V(6); PG8_BAR;
    } else {
        PG8_STAGE(PG8_SB(0, 0), cB, voffB); PG8_STAGE(PG8_SA(0, 0), cA, voffA); PG8_STAGE(PG8_SB(0, 1), cB + hstep, voffB); PG8_STAGE(PG8_SA(0, 1), cA + hstep, voffA);
        if (wr == 1) PG8_BAR;
        PG8_WAIT_V(4); PG8_BAR;
        PG8_STAGE(PG8_SB(1, 0), cB + kstep, voffB); PG8_STAGE(PG8_SA(1, 0), cA + kstep, voffA); PG8_STAGE(PG8_SB(1, 1), cB + hstep + kstep, voffB);
        PG8_WAIT_V(6); PG8_BAR;
    }
    for (;;) {
        const bool has_next = S.next(ui + 1, nxt);
        const char* nA = has_next ? (const char*)g.A + (size_t)nxt.pm * tstep : cA; const char* nB = has_next ? (const char*)g.Bt + (size_t)nxt.pn * tstep : cB;
#pragma unroll 1
        for (int t = 0; t < nt; t += 2) {
            const bool last = (t == nt - 2);
            const char* a1 = cA + (size_t)(t + 1) * kstep;
            const char* a2 = last ? nA : cA + (size_t)(t + 2) * kstep; const char* b2 = last ? nB : cB + (size_t)(t + 2) * kstep;
            const char* a3 = a2 + kstep; const char* b3 = b2 + kstep;
            if (last && has_next) S.a_ready(nxt);
            if constexpr (SP2) {
            PG8_LDB(B0, 0, 0); PG8_LDB(B1, 0, 1); PG8_SCHED; PG8_LDA(At, 0, 0); PG8_STAGE(PG8_SA(1, 1), a1 + hstep, voffA);
            PG8_WAIT_V(8); PG8_WAIT_L(0); PG8_BAR; PG8_MMA(0, 0, At, B0); PG8_MMA(0, 1, At, B1); PG8_BAR; PG8_SCHED;
            PG8_LDA(At, 0, 1); PG8_STAGE(PG8_SB(0, 0), b2, voffB); PG8_STAGE(PG8_SB(0, 1), b2 + hstep, voffB); PG8_STAGE(PG8_SA(0, 0), a2, voffA);
            PG8_WAIT_V(8); PG8_WAIT_L(0); PG8_BAR; PG8_MMA(1, 0, At, B0); PG8_MMA(1, 1, At, B1); PG8_BAR; PG8_SCHED;
            PG8_LDB(B0, 1, 0); PG8_LDB(B1, 1, 1); PG8_SCHED; PG8_LDA(At, 1, 0); PG8_STAGE(PG8_SA(0, 1), a2 + hstep, voffA);
            PG8_WAIT_V(8); PG8_WAIT_L(0); PG8_BAR; PG8_MMA(0, 0, At, B0); PG8_MMA(0, 1, At, B1); PG8_BAR; PG8_SCHED;
            PG8_LDA(At, 1, 1); PG8_STAGE(PG8_SB(1, 0), b3, voffB); PG8_STAGE(PG8_SB(1, 1), b3 + hstep, voffB); PG8_STAGE(PG8_SA(1, 0), a3, voffA);
            PG8_WAIT_V(8); PG8_WAIT_L(0); PG8_BAR; PG8_MMA(1, 0, At, B0); PG8_MMA(1, 1, At, B1); PG8_BAR; PG8_SCHED;
            } else {
            PG8_LDB(B0, 0, 0); PG8_SCHED; PG8_LDA(At, 0, 0); PG8_STAGE(PG8_SA(1, 1), a1 + hstep, voffA);
            PG8_WAIT_L(8); PG8_BAR; PG8_WAIT_L(0); PG8_MMA(0, 0, At, B0); PG8_BAR; PG8_SCHED;
            PG8_LDB(B1, 0, 1); PG8_STAGE(PG8_SB(0, 0), b2, voffB);
            PG8_BAR; PG8_WAIT_L(0); PG8_MMA(0, 1, At, B1); PG8_BAR;
            PG8_LDA(At, 0, 1); PG8_STAGE(PG8_SA(0, 0), a2, voffA);
            PG8_BAR; PG8_WAIT_L(0); PG8_MMA(1, 0, At, B0); PG8_BAR; PG8_SCHED;
            PG8_STAGE(PG8_SB(0, 1), b2 + hstep, voffB);
            PG8_WAIT_V(6); PG8_BAR; PG8_MMA(1, 1, At, B1); PG8_BAR;
            PG8_LDB(B0, 1, 0); PG8_SCHED; PG8_LDA(At, 1, 0); PG8_STAGE(PG8_SA(0, 1), a2 + hstep, voffA);
            PG8_WAIT_L(8); PG8_BAR; PG8_WAIT_L(0); PG8_MMA(0, 0, At, B0); PG8_BAR; PG8_SCHED;
            PG8_LDB(B1, 1, 1); PG8_STAGE(PG8_SB(1, 0), b3, voffB);
            PG8_BAR; PG8_WAIT_L(0); PG8_MMA(0, 1, At, B1); PG8_BAR;
            PG8_LDA(At, 1, 1); PG8_STAGE(PG8_SA(1, 0), a3, voffA);
            PG8_BAR; PG8_WAIT_L(0); PG8_MMA(1, 0, At, B0); PG8_BAR; PG8_SCHED;
            PG8_STAGE(PG8_SB(1, 1), b3 + hstep, voffB);
            PG8_WAIT_V(6); PG8_BAR; PG8_MMA(1, 1, At, B1); PG8_BAR;
            }
        }
        if constexpr (ALIGN_EPI) { if (wr == 0) PG8_BAR; }
        E(acc, cur, wr, wc, fr, fq); S.done(cur);
        if (!has_next) break;
        if (!E.keep_acc(cur)) {
#pragma unroll
        for (int a = 0; a < 2; ++a)
#pragma unroll
            for (int b = 0; b < 2; ++b)
#pragma unroll
                for (int m = 0; m < 4; ++m)
#pragma unroll
                    for (int n = 0; n < 2; ++n) acc[a][b][m][n] = (f32x4){0.f, 0.f, 0.f, 0.f};
        }
        cur = nxt; cA = nA; cB = nB; ++ui;
        if constexpr (ALIGN_EPI) { if (wr == 1) PG8_BAR; }
    }
    PG8_WAIT_V(0);
    if constexpr (!ALIGN_EPI) { if (wr == 0) PG8_BAR; }
    PG8_BAR;
#undef PG8_SA
#undef PG8_SB
#undef PG8_STAGE
#undef PG8_LDA
#undef PG8_LDB
#undef PG8_MMA
#undef PG8_WAIT_V
#undef PG8_WAIT_L
#undef PG8_BAR
#undef PG8_SCHED
}
}

typedef const f32x4 (&AccRef)[2][2][4][2];
typedef f32x4 (&AccMut)[2][2][4][2];

template <int ACT> __device__ __forceinline__ void store_bf16_tile(AccRef acc, bf16_t* base, int ld, int row0, int cl0) {
#pragma unroll
    for (int ai = 0; ai < 2; ++ai)
#pragma unroll
        for (int m = 0; m < 4; ++m) { bf16_t* rp = base + (size_t)(row0 + ai * 128 + m * 16) * ld + cl0;
#pragma unroll
            for (int bj = 0; bj < 2; ++bj) { f32x4 v0 = acc[ai][bj][m][0], v1 = acc[ai][bj][m][1];
                if (ACT == 1) {
#pragma unroll
                    for (int j = 0; j < 4; ++j) { v0[j] = siluf_(v0[j]); v1[j] = siluf_(v1[j]); } }
                if (ACT == 2) {
#pragma unroll
                    for (int j = 0; j < 4; ++j) { v0[j] = sigmoidf_(v0[j]); v1[j] = sigmoidf_(v1[j]); } }
                u32x4 w; w.x = pk2(v0[0], v0[1]); w.y = pk2(v0[2], v0[3]); w.z = pk2(v1[0], v1[1]); w.w = pk2(v1[2], v1[3]);
                *(u32x4*)(rp + bj * 128) = w; } }
}
__device__ __forceinline__ void store_vt_tile(AccRef acc, bf16_t* VT, int h0, int row0, int cl0, const float* rscale) {
#pragma unroll
    for (int ai = 0; ai < 2; ++ai)
#pragma unroll
        for (int m = 0; m < 4; ++m) { const int row = row0 + ai * 128 + m * 16; const int b = row >> 11, s = row & 2047; const float rs = rscale ? rscale[ai * 4 + m] : 1.f;
#pragma unroll
            for (int bj = 0; bj < 2; ++bj) { const unsigned po = (unsigned)(((b * 8 + h0 + bj) * 128 + cl0) * 2048 + s);
#pragma unroll
                for (int n = 0; n < 2; ++n)
#pragma unroll
                    for (int j = 0; j < 4; ++j) VT[po + (unsigned)((4 * n + j) * 2048)] = f2bf(acc[ai][bj][m][n][j] * rs); }
            asm volatile("" ::: "memory"); }
}

struct Epi1 {
    static constexpr bool PERM = true;
    __device__ __forceinline__ bool keep_acc(const pg8::Unit&) const { return false; }
    unsigned char* ws;
    __device__ __forceinline__ void operator()(AccRef acc, const pg8::Unit& u, int wr, int wc, int fr, int fq) const {
        const int pn = (13 * u.pn) & 63, row0 = u.pm * 256 + wr * 64 + fr, cl0 = wc * 32 + 8 * fq;
        if (pn < 3) {
            bf16_t* base; int ld, slot;
            if (pn < 2) { base = (bf16_t*)(ws + WS_CQ) + pn * 256; ld = 512; slot = pn * 4 + wc; } else { base = (bf16_t*)(ws + WS_CKV); ld = 256; slot = 8 + wc; }
            float* ssq = (float*)(ws + WS_SSQ);
#pragma unroll
            for (int ai = 0; ai < 2; ++ai)
#pragma unroll
                for (int m = 0; m < 4; ++m) { const int row = row0 + ai * 128 + m * 16; bf16_t* rp = base + (size_t)row * ld + cl0; float ss = 0.f;
#pragma unroll
                    for (int bj = 0; bj < 2; ++bj) { const f32x4 v0 = acc[ai][bj][m][0], v1 = acc[ai][bj][m][1];
                        ss += (v0[0] * v0[0] + v0[1] * v0[1]) + (v0[2] * v0[2] + v0[3] * v0[3]) + (v1[0] * v1[0] + v1[1] * v1[1]) + (v1[2] * v1[2] + v1[3] * v1[3]);
                        u32x4 w; w.x = pk2(v0[0], v0[1]); w.y = pk2(v0[2], v0[3]); w.z = pk2(v1[0], v1[1]); w.w = pk2(v1[2], v1[3]);
                        *(u32x4*)(rp + bj * 128) = w; }
                    ss += __shfl_xor(ss, 16); ss += __shfl_xor(ss, 32);
                    if (fq == 0) ssq[(size_t)row * 16 + slot] = ss; }
        } else if (pn == 63) {
            float* misc = (float*)(ws + WS_MISC);
#pragma unroll
            for (int ai = 0; ai < 2; ++ai)
#pragma unroll
                for (int m = 0; m < 4; ++m) { float* rp = misc + (size_t)(row0 + ai * 128 + m * 16) * 128 + cl0;
                    *(f32x4*)(rp) = acc[ai][0][m][0]; *(f32x4*)(rp + 4) = acc[ai][0][m][1]; }
        } else if (pn >= 39) {
            store_bf16_tile<2>(acc, (bf16_t*)(ws + WS_MG) + (pn - 39) * 256, 6144, row0, cl0);
        } else {
            const int seg = (pn - 3) >> 2, ct = (pn - 3) & 3;
            if (seg == 0 || seg == 4 || seg == 8) store_bf16_tile<1>(acc, (bf16_t*)(ws + WS_SG) + (size_t)(seg >> 2) * T * 1024 + ct * 256, 1024, row0, cl0);
            else if (seg == 3) store_vt_tile(acc, (bf16_t*)(ws + WS_VBT), ct * 2, row0, cl0, nullptr);
            else if (seg == 7) store_vt_tile(acc, (bf16_t*)(ws + WS_VCT), ct * 2, row0, cl0, nullptr);
            else { const size_t off = seg == 1 ? WS_QB : seg == 2 ? WS_KB : seg == 5 ? WS_QC : WS_KC; store_bf16_tile<0>(acc, (bf16_t*)(ws + off) + ct * 256, 1024, row0, cl0); }
        }
    }
};

template <int WHICH  > struct Epi2 {
    static constexpr bool PERM = true;
    __device__ __forceinline__ bool keep_acc(const pg8::Unit&) const { return false; }
    unsigned char* ws;
    __device__ __forceinline__ float rstd(int row) const {
        const float* ssq = (const float*)(ws + WS_SSQ) + (size_t)row * 16 + (WHICH ? 8 : 0);
        const f32x4 a = *(const f32x4*)ssq; float s = (a[0] + a[1]) + (a[2] + a[3]);
        if (WHICH == 0) { const f32x4 b = *(const f32x4*)(ssq + 4); s += (b[0] + b[1]) + (b[2] + b[3]); }
        return rsqrtf(s * (WHICH ? (1.f / 256.f) : (1.f / 512.f)) + 1e-6f);
    }
    __device__ __forceinline__ void operator()(AccRef acc, const pg8::Unit& u, int wr, int wc, int fr, int fq) const {
        const int pn = u.pn, row0 = u.pm * 256 + wr * 64 + fr, cl0 = wc * 32 + 8 * fq;
        if (pn < 4) {
            bf16_t* base = (bf16_t*)(ws + (WHICH ? WS_KAN : WS_QAN)) + pn * 256;
#pragma unroll
            for (int ai = 0; ai < 2; ++ai)
#pragma unroll
                for (int m = 0; m < 4; ++m) { const int row = row0 + ai * 128 + m * 16; bf16_t* rp = base + (size_t)row * 1024 + cl0; const float r = rstd(row);
#pragma unroll
                    for (int bj = 0; bj < 2; ++bj) { const f32x4 v0 = acc[ai][bj][m][0] * r, v1 = acc[ai][bj][m][1] * r;
                        u32x4 w; w.x = pk2(v0[0], v0[1]); w.y = pk2(v0[2], v0[3]); w.z = pk2(v1[0], v1[1]); w.w = pk2(v1[2], v1[3]);
                        *(u32x4*)(rp + bj * 128) = w; }
                    asm volatile("" ::: "memory"); }
        } else if (WHICH == 1) {
            bf16_t* VT = (bf16_t*)(ws + WS_VAT); const int h0 = (pn - 4) * 2;
#pragma unroll
            for (int ai = 0; ai < 2; ++ai)
#pragma unroll
                for (int m = 0; m < 4; ++m) { const int row = row0 + ai * 128 + m * 16; const int b = row >> 11, s = row & 2047; const float rs = rstd(row);
#pragma unroll
                    for (int bj = 0; bj < 2; ++bj) { const unsigned po = (unsigned)(((b * 8 + h0 + bj) * 128 + cl0) * 2048 + s);
#pragma unroll
                        for (int n = 0; n < 2; ++n)
#pragma unroll
                            for (int j = 0; j < 4; ++j) VT[po + (unsigned)((4 * n + j) * 2048)] = f2bf(acc[ai][bj][m][n][j] * rs); }
                    asm volatile("" ::: "memory"); }
        } else {
            bf16_t* base = (bf16_t*)(ws + WS_QAR) + (pn - 4) * 256;
            const f32x2* cs = (const f32x2*)(ws + WS_CS);
#pragma unroll
            for (int ai = 0; ai < 2; ++ai)
#pragma unroll
                for (int m = 0; m < 4; ++m) { const int row = row0 + ai * 128 + m * 16; bf16_t* rp = base + (size_t)row * 512 + cl0; const float r = rstd(row);
#pragma unroll
                    for (int bj = 0; bj < 2; ++bj) { const int j0 = ((bj * 128 + cl0) & 63) >> 1;
                        const f32x4 c01 = *(const f32x4*)(cs + (size_t)row * 32 + j0), c23 = *(const f32x4*)(cs + (size_t)row * 32 + j0 + 2);
                        const f32x4 v0 = acc[ai][bj][m][0] * r, v1 = acc[ai][bj][m][1] * r;
                        u32x4 w;
                        w.x = pk2(v0[0] * c01[0] - v0[1] * c01[1], v0[1] * c01[0] + v0[0] * c01[1]);
                        w.y = pk2(v0[2] * c01[2] - v0[3] * c01[3], v0[3] * c01[2] + v0[2] * c01[3]);
                        w.z = pk2(v1[0] * c23[0] - v1[1] * c23[1], v1[1] * c23[0] + v1[0] * c23[1]);
                        w.w = pk2(v1[2] * c23[2] - v1[3] * c23[3], v1[3] * c23[2] + v1[2] * c23[3]);
                        *(u32x4*)(rp + bj * 128) = w; }
                    asm volatile("" ::: "memory"); }
        }
    }
};

__device__ __forceinline__ void unpack_gate(const u32x4 gw, f32x4& g0, f32x4& g1) {
    g0[0] = __uint_as_float(gw.x << 16); g0[1] = __uint_as_float(gw.x & 0xffff0000u); g0[2] = __uint_as_float(gw.y << 16); g0[3] = __uint_as_float(gw.y & 0xffff0000u);
    g1[0] = __uint_as_float(gw.z << 16); g1[1] = __uint_as_float(gw.z & 0xffff0000u); g1[2] = __uint_as_float(gw.w << 16); g1[3] = __uint_as_float(gw.w & 0xffff0000u);
}
struct Epi3 {
    static constexpr bool PERM = true;
    __device__ __forceinline__ bool keep_acc(const pg8::Unit& u) const { return (u.pm >> 5) < 2; }
    unsigned char* ws;
    __device__ __forceinline__ void operator()(AccMut acc, const pg8::Unit& u, int wr, int wc, int fr, int fq) const {
        const int n = u.pm >> 5, pm = u.pm & 31, pn = u.pn & 7;
        const int row0 = pm * 256 + wr * 64 + fr, col0 = pn * 256 + wc * 32 + 8 * fq;
        const bf16_t* mg = (const bf16_t*)(ws + WS_MG) + n * 2048; bf16_t* mrg = (bf16_t*)(ws + WS_MRG);
#pragma unroll
        for (int ai = 0; ai < 2; ++ai)
#pragma unroll
            for (int m = 0; m < 4; ++m) { const int row = row0 + ai * 128 + m * 16;
#pragma unroll
                for (int bj = 0; bj < 2; ++bj) { const int col = col0 + bj * 128;
                    f32x4 g0, g1; unpack_gate(*(const u32x4*)(mg + (size_t)row * 6144 + col), g0, g1);
#pragma unroll
                    for (int j = 0; j < 4; ++j) { g0[j] = fmaxf(g0[j], 1e-20f); g1[j] = fmaxf(g1[j], 1e-20f); }
                    if (n < 2) { f32x4 h0, h1; unpack_gate(*(const u32x4*)(mg + (size_t)row * 6144 + 2048 + col), h0, h1);
#pragma unroll
                        for (int j = 0; j < 4; ++j) { g0[j] *= __builtin_amdgcn_rcpf(fmaxf(h0[j], 1e-20f)); g1[j] *= __builtin_amdgcn_rcpf(fmaxf(h1[j], 1e-20f)); }
                        acc[ai][bj][m][0] *= g0; acc[ai][bj][m][1] *= g1;
                    } else {
                        const f32x4 v0 = acc[ai][bj][m][0] * g0, v1 = acc[ai][bj][m][1] * g1;
                        u32x4 w; w.x = pk2(v0[0], v0[1]); w.y = pk2(v0[2], v0[3]); w.z = pk2(v1[0], v1[1]); w.w = pk2(v1[2], v1[3]); *(u32x4*)(mrg + (size_t)row * 2048 + col) = w; } } }
    }
};

struct Epi4 {
    static constexpr bool PERM = true;
    __device__ __forceinline__ bool keep_acc(const pg8::Unit&) const { return false; }
    bf16_t* O;
    __device__ __forceinline__ void operator()(AccRef acc, const pg8::Unit& u, int wr, int wc, int fr, int fq) const {
        store_bf16_tile<0>(acc, O + u.pn * 256, 2048, u.pm * 256 + wr * 64 + fr, wc * 32 + 8 * fq);
    }
};

__device__ __forceinline__ int map_bt1(int n, float& sc) {
    n = (((13 * (n >> 8)) & 63) << 8) | (n & 255);
    sc = 1.f;
    if (n < 768) return n;
    if (n < 1792) return 832 + (n - 768);
    if (n < 2816) { sc = LOG2E * 0.08838834764831845f; return 1856 + (n - 1792); }
    if (n < 3840) return 2880 + (n - 2816);
    if (n < 4864) return 3904 + (n - 3840);
    if (n < 5888) return 4936 + (n - 4864);
    if (n < 6912) { sc = LOG2E * 0.08838834764831845f; return 5960 + (n - 5888); }
    if (n < 7936) return 6984 + (n - 6912);
    if (n < 8960) return 8008 + (n - 7936);
    if (n < 9984) return 9032 + (n - 8960);
    if (n < 16128) return 10056 + (n - 9984);
    const int r = n - 16128;
    if (r < 64) return 768 + 32 * (r & 1) + (r >> 1);
    if (r < 72) return 4928 + (r - 64);
    return -1;
}
constexpr int CT_BT1 = 128 * 16, CT_BT2Q = 12 * 4, CT_BT2KV = 16 * 2, CT_BT3 = 3 * 16 * 8, CT_BT4 = 16 * 16, CT_LAYER = CT_BT1 + CT_BT2Q + CT_BT2KV + CT_BT3 + CT_BT4;
constexpr int NJ_MOD = 192, NJ_CS = 64, NJ_CONV = NLAYER * CT_LAYER, NJ_TOTAL = NJ_MOD + NJ_CS + NJ_CONV;

__device__ __forceinline__ void conv_tile(const Params& P, int job, LAS unsigned char* lds) {
    const int tid = my_tid();
    const int l = job / CT_LAYER; int r = job % CT_LAYER;
    unsigned char* wl = P.ws + WS_W + (size_t)l * SZ_WL;
    int kind, nt, kt; const float* src; int ld; bf16_t* dst; int Kd; const float* gain = nullptr; float gsc = 1.f;
    if (r < CT_BT1) { kind = 0; nt = r >> 4; kt = r & 15; src = P.w_in + (size_t)l * DM * DIN; ld = DIN; dst = (bf16_t*)wl; Kd = 2048; }
    else if ((r -= CT_BT1) < CT_BT2Q) { kind = 1; nt = r >> 2; kt = r & 3; src = P.w_uq + (size_t)l * 512 * 1536; ld = 1536; dst = (bf16_t*)(wl + OFF_BT2Q); Kd = 512; gain = P.qng + l * 512; gsc = LOG2E * 0.07216878364870323f; }
    else if ((r -= CT_BT2Q) < CT_BT2KV) { kind = 2; nt = r >> 1; kt = r & 1; src = P.w_ukv + (size_t)l * 256 * 2048; ld = 2048; dst = (bf16_t*)(wl + OFF_BT2KV); Kd = 256; gain = P.kvng + l * 256; }
    else if ((r -= CT_BT2KV) < CT_BT3) { kind = 3; const int br = r >> 7; r &= 127; nt = r >> 3; kt = r & 7; src = P.w_branch + ((size_t)l * 3 + br) * 1024 * 2048; ld = 2048; dst = (bf16_t*)(wl + OFF_BT3) + (size_t)br * 2048 * 1024; Kd = 1024; }
    else { r -= CT_BT3; kind = 4; nt = r >> 4; kt = r & 15; src = P.w_out + (size_t)l * 2048 * 2048; ld = 2048; dst = (bf16_t*)(wl + OFF_BT4); Kd = 2048; }
    const int nl = tid & 127, kb = tid >> 7, n = nt * 128 + nl;
    int sc_col; float sc = 1.f;
    if (kind == 0) sc_col = map_bt1(n, sc);
    else if (kind == 1) { if (n < 1024) sc_col = (n >> 7) * 192 + (n & 127); else { const int q = n - 1024, h = q >> 6, rr = q & 63; sc_col = h * 192 + 128 + 32 * (rr & 1) + (rr >> 1); } sc = gsc; }
    else if (kind == 2) { if (n < 1024) sc_col = (n >> 7) * 256 + (n & 127); else { const int q = n - 1024; sc_col = (q >> 7) * 256 + 128 + (q & 127); } }
    else sc_col = n;
    LAS bf16_t* tl = (LAS bf16_t*)lds;
    const float* sp = src + (size_t)(kt * 128 + kb) * ld + (sc_col < 0 ? 0 : sc_col);
    float v[32];
#pragma unroll
    for (int i = 0; i < 32; ++i) v[i] = (sc_col >= 0) ? __builtin_nontemporal_load(sp + (size_t)(4 * i) * ld) : 0.f;
#pragma unroll
    for (int i = 0; i < 32; ++i) { float g = sc; if (gain) g *= gain[kt * 128 + kb + 4 * i]; tl[nl * 130 + kb + 4 * i] = f2bf(v[i] * g); }
    __syncthreads();
    const int nr = tid >> 2, kc = tid & 3;
    const LAS unsigned* rp = (const LAS unsigned*)(lds + (nr * 130 + kc * 32) * 2);
    bf16_t* dp = dst + (size_t)(nt * 128 + nr) * Kd + kt * 128 + kc * 32;
#pragma unroll
    for (int q = 0; q < 4; ++q) { u32x4 w; w.x = rp[4 * q]; w.y = rp[4 * q + 1]; w.z = rp[4 * q + 2]; w.w = rp[4 * q + 3]; *(u32x4*)(dp + 8 * q) = w; }
}

__device__ __forceinline__ void mod_job(const Params& P, int job, LAS unsigned char* lds) {
    const int tid = my_tid(), l = job / 48, ct = job % 48;
    LAS float* cl = (LAS float*)lds;
    LAS float* part = (LAS float*)(lds + 32768);
    for (int i = tid; i < 4 * 2048; i += 512) cl[i] = P.c[i];
    __syncthreads();
    const int col = ct * 128 + (tid & 127), kg = tid >> 7;
    const float* wp = P.w_ada + (size_t)l * 2048 * 6144 + (size_t)(kg * 512) * 6144 + col;
    float a0 = 0.f, a1 = 0.f, a2 = 0.f, a3 = 0.f;
    for (int k = 0; k < 512; k += 8) {
        float w[8];
#pragma unroll
        for (int j = 0; j < 8; ++j) w[j] = __builtin_nontemporal_load(wp + (size_t)(k + j) * 6144);
#pragma unroll
        for (int j = 0; j < 8; ++j) { const int kk = kg * 512 + k + j; a0 += cl[kk] * w[j]; a1 += cl[2048 + kk] * w[j]; a2 += cl[4096 + kk] * w[j]; a3 += cl[6144 + kk] * w[j]; }
    }
    part[(kg * 4 + 0) * 128 + (tid & 127)] = a0; part[(kg * 4 + 1) * 128 + (tid & 127)] = a1; part[(kg * 4 + 2) * 128 + (tid & 127)] = a2; part[(kg * 4 + 3) * 128 + (tid & 127)] = a3;
    __syncthreads();
    { const int b = tid >> 7, c = tid & 127; const float s = part[(0 * 4 + b) * 128 + c] + part[(1 * 4 + b) * 128 + c] + part[(2 * 4 + b) * 128 + c] + part[(3 * 4 + b) * 128 + c];
      ((float*)(P.ws + WS_MOD))[((size_t)l * 4 + b) * 6144 + ct * 128 + c] = s + P.b_ada[(size_t)l * 6144 + ct * 128 + c]; }
}

__device__ __forceinline__ void cs_job(const Params& P, int job) {
    f32x2* cs = (f32x2*)(P.ws + WS_CS);
    const int tid = my_tid();
#pragma unroll
    for (int i = 0; i < 8; ++i) { const int idx = job * 4096 + i * 512 + tid; const int tok = idx >> 5, j = idx & 31;
        double pw = 1.0, bs = 0.749894209332456; { if (j & 1) pw *= bs; bs *= bs; if (j & 2) pw *= bs; bs *= bs; if (j & 4) pw *= bs; bs *= bs; if (j & 8) pw *= bs; bs *= bs; if (j & 16) pw *= bs; }
        const float ang = (float)P.pos[tok] * (float)pw;
        double rev = (double)ang * 0.15915494309189535; rev -= __builtin_rint(rev);
        const float rf = (float)rev;
        cs[idx] = (f32x2){__builtin_amdgcn_cosf(rf), __builtin_amdgcn_sinf(rf)}; }
}

__device__ __forceinline__ void phase_prologue(const Params& P, LAS unsigned char* lds, int ci) {
    const int G = my_G(), c = my_bx();
    if (G == 256) {
        static_assert(NJ_MOD == 192 && NJ_CS == 64 && NJ_CONV == 41 * 256 + 9 * 64, "static prologue deal");
        if (c < NJ_MOD) mod_job(P, c, lds); else cs_job(P, c - NJ_MOD);
#pragma unroll 1
        for (int r = 0; r < 41; ++r) { __syncthreads(); conv_tile(P, r * 256 + c, lds); }
        if (c >= NJ_MOD) {
#pragma unroll 1
            for (int j = 0; j < 9; ++j) { __syncthreads(); conv_tile(P, 41 * 256 + (c - NJ_MOD) + 64 * j, lds); }
        }
        __syncthreads();
        return;
    }
    unsigned* ctr = (unsigned*)(P.ws + WS_CTR) + ci * 16;
    LAS int* slot = (LAS int*)(lds + 131072);
    const int tid0 = my_tid();
    for (;;) {
        __syncthreads();
        if (tid0 == 0) *slot = (int)atomicAdd(ctr, 1u);
        __syncthreads();
        const int job = *slot;
        if (job >= NJ_TOTAL) break;
        if (job < NJ_MOD) mod_job(P, job, lds);
        else if (job < NJ_MOD + NJ_CS) cs_job(P, job - NJ_MOD);
        else conv_tile(P, job - NJ_MOD - NJ_CS, lds);
    }
}

__device__ __forceinline__ void row_stats(const f32x4 (&v)[8], float& mean, float& rstd) {
    float s = 0.f;
#pragma unroll
    for (int i = 0; i < 8; ++i) s += (v[i][0] + v[i][1]) + (v[i][2] + v[i][3]);
    mean = wave_sum(s) * (1.f / 2048.f);
    float q = 0.f;
#pragma unroll
    for (int i = 0; i < 8; ++i) { const f32x4 d = v[i] - mean; q += (d[0] * d[0] + d[1] * d[1]) + (d[2] * d[2] + d[3] * d[3]); }
    rstd = rsqrtf(wave_sum(q) * (1.f / 2048.f) + 1e-5f);
}
__device__ __forceinline__ void phase_ln(const Params& P, int l) {
    const int tid = my_tid(), bx = my_bx(), G = my_G();
    const int wid = tid >> 6, lane = tid & 63;
    float* X = (float*)(P.ws + WS_X); bf16_t* U = (bf16_t*)(P.ws + WS_U);
    const float* xsrc = (l <= 1) ? P.x : X;
    const bf16_t* outb = (const bf16_t*)(P.ws + WS_MRG2);
    const float* g = P.ln_g + (size_t)(l > 0 ? l - 1 : 0) * 2048; const float* bb = P.ln_b + (size_t)(l > 0 ? l - 1 : 0) * 2048;
    const float* mod = (const float*)(P.ws + WS_MOD) + (size_t)(l < 4 ? l : 0) * 4 * 6144;
    const float* gate = (const float*)(P.ws + WS_MOD) + (size_t)(l > 0 ? l - 1 : 0) * 4 * 6144 + 4096;
    for (int row = bx * 8 + wid; row < T; row += G * 8) {
        f32x4 v[8];
#pragma unroll
        for (int i = 0; i < 8; ++i) v[i] = *(const f32x4*)(xsrc + (size_t)row * 2048 + (i * 64 + lane) * 4);
        if (l >= 1) {
            const float* gp = gate + (size_t)(row >> 11) * 6144;
#pragma unroll
            for (int i = 0; i < 8; ++i) { const int col = (i * 64 + lane) * 4; const u32x2 ow = *(const u32x2*)(outb + (size_t)row * 2048 + col); const f32x4 gv = *(const f32x4*)(gp + col);
                f32x4 o; o[0] = __uint_as_float(ow.x << 16); o[1] = __uint_as_float(ow.x & 0xffff0000u); o[2] = __uint_as_float(ow.y << 16); o[3] = __uint_as_float(ow.y & 0xffff0000u);
                v[i] = v[i] * ALPHA + gv * o; }
        }
        float mean, rstd; row_stats(v, mean, rstd);
        if (l >= 1) {
            float* dst = (l == 4) ? P.out : X;
#pragma unroll
            for (int i = 0; i < 8; ++i) { const int col = (i * 64 + lane) * 4; const f32x4 gv = *(const f32x4*)(g + col), bv = *(const f32x4*)(bb + col);
                v[i] = (v[i] - mean) * rstd * gv + bv; *(f32x4*)(dst + (size_t)row * 2048 + col) = v[i]; }
            if (l == 4) continue;
            row_stats(v, mean, rstd);
        }
        const float* mp = mod + (size_t)(row >> 11) * 6144;
#pragma unroll
        for (int i = 0; i < 8; ++i) { const int col = (i * 64 + lane) * 4; const f32x4 sh = *(const f32x4*)(mp + col), sc = *(const f32x4*)(mp + 2048 + col);
            const f32x4 uu = (v[i] - mean) * rstd * (sc + 1.f) + sh; u32x2 w; w.x = pk2(uu[0], uu[1]); w.y = pk2(uu[2], uu[3]);
            *(u32x2*)(U + (size_t)row * 2048 + col) = w; }
    }
}

__device__ __forceinline__ void phase_small(const Params& P, int l) {
    const float* misc = (const float*)(P.ws + WS_MISC); const f32x2* cs = (const f32x2*)(P.ws + WS_CS); bf16_t* kr = (bf16_t*)(P.ws + WS_KR);
    const int tid = my_tid(), bx = my_bx(), G = my_G();
    const int rb0 = (G == 256) ? 192 : 0, rnb = G - rb0;
    for (int idx = (bx - rb0) * 512 + tid; idx < T * 32 && bx >= rb0; idx += rnb * 512) { const int tok = idx >> 5, j = idx & 31;
        const f32x2 x = *(const f32x2*)(misc + (size_t)tok * 128 + 2 * j); const f32x2 c = cs[idx];
        *(unsigned*)(kr + (size_t)tok * 64 + 2 * j) = pk2(x[0] * c[0] - x[1] * c[1], x[1] * c[0] + x[0] * c[1]); }
    const int wid = tid >> 6, lane = tid & 63;
    const int fb0 = (G >= 200) ? 192 : 0;
    for (int sid = (bx - fb0) * 8 + wid; sid < 32 && bx >= fb0; sid += G * 8) { const int b = sid >> 3, h = sid & 7; const float bias = P.fox_bias[l * 8 + h];
        float loc[32]; float run = 0.f;
#pragma unroll
        for (int i = 0; i < 32; ++i) { const int s = lane * 32 + i; const float xx = misc[(size_t)(b * 2048 + s) * 128 + 64 + h] + bias;
            const float ls = -(fmaxf(-xx, 0.f) + log1pf(expf(-fabsf(xx)))); run += ls; loc[i] = run; }
        float incl = run;
#pragma unroll
        for (int o = 1; o < 64; o <<= 1) { const float t = __shfl_up(incl, o); if (lane >= o) incl += t; }
        const float excl = incl - run; float* fc = (float*)(P.ws + WS_FC) + (size_t)sid * 2048 + lane * 32;
#pragma unroll
        for (int i = 0; i < 32; ++i) fc[i] = (loc[i] + excl) * LOG2E; }
}

#define MFMA32(a, b, c) __builtin_amdgcn_mfma_f32_32x32x16_bf16((a), (b), (c), 0, 0, 0)
__device__ __forceinline__ bf16x8 pack8(const f32x16& x, int s) {
    u32x4 p;
    if (s == 0) { p.x = pk2(x[0], x[1]); p.y = pk2(x[2], x[3]); p.z = pk2(x[4], x[5]); p.w = pk2(x[6], x[7]); }
    else { p.x = pk2(x[8], x[9]); p.y = pk2(x[10], x[11]); p.z = pk2(x[12], x[13]); p.w = pk2(x[14], x[15]); }
    return __builtin_bit_cast(bf16x8, p);
}
__device__ __forceinline__ float exp2_negabs(float x) { float r; asm("v_exp_f32 %0, -|%1|\n\ts_nop 1" : "=v"(r) : "v"(x)); return r; }
__device__ __forceinline__ void sb_sub(f32x16& s, float& carry, const int hh) {
    float w[16];
#pragma unroll
    for (int i = 0; i < 16; ++i) { const float z = s[i]; const float t = log2_(1.f + exp2_negabs(z));
        w[i] = -(__builtin_fmaxf(z, 0.f) + t); }
    const float GA = ((w[0] + w[1]) + (w[2] + w[3])) + ((w[4] + w[5]) + (w[6] + w[7])), GB = ((w[8] + w[9]) + (w[10] + w[11])) + ((w[12] + w[13]) + (w[14] + w[15]));
    const float GAp = swap_partner(GA, hh), GBp = swap_partner(GB, hh);
    float a = carry + (hh == 0 ? GBp : 0.f);
#pragma unroll
    for (int i = 15; i >= 8; --i) { const float wi = w[i]; s[i] = exp2_((s[i] + wi) + a); a += wi; }
    a = carry + GB + GBp + (hh == 0 ? GAp : 0.f);
#pragma unroll
    for (int i = 7; i >= 0; --i) { const float wi = w[i]; s[i] = exp2_((s[i] + wi) + a); a += wi; }
    carry += (GA + GB) + (GAp + GBp);
}

template <int N> __device__ __forceinline__ void at_waitv() {
    if constexpr (N == 0) asm volatile("s_waitcnt vmcnt(0)" ::: "memory");
    else if constexpr (N == 2) asm volatile("s_waitcnt vmcnt(2)" ::: "memory");
    else if constexpr (N == 3) asm volatile("s_waitcnt vmcnt(3)" ::: "memory");
    else if constexpr (N == 4) asm volatile("s_waitcnt vmcnt(4)" ::: "memory");
    else if constexpr (N == 5) asm volatile("s_waitcnt vmcnt(5)" ::: "memory");
    else static_assert(N == 0, "at_waitv: add the count");
}
#define AT_BAR() do { asm volatile("" ::: "memory"); __builtin_amdgcn_s_barrier(); asm volatile("" ::: "memory"); } while (0)
template <int TYPE  >
__device__ __forceinline__ void attn_item(const Params& P, const int b, const int h, const int qt, LAS unsigned char* lds) {
    constexpr int DQK = TYPE == 0 ? 192 : 128, KS = DQK / 16, KROWB = DQK * 2, KREG = 64 * KROWB, VREG = 16384, FREG = TYPE == 1 ? 2048 : 0, SLOT = KREG + VREG + FREG;
    constexpr int NKI = KREG / 8192, NI = NKI + 2 + (TYPE == 1 ? 1 : 0), FLAGS = 126976;
    static_assert(3 * SLOT <= FLAGS && SLOT % 256 == 0, "ring");
    const int tid = my_tid(), wid = __builtin_amdgcn_readfirstlane(tid >> 6), lane = tid & 63, l32 = lane & 31, hh = lane >> 5;
    unsigned char* ws = P.ws;
    const int bh = b * 8 + h;
    const int tq = qt * 256 + wid * 32 + l32;
    const size_t tokq = (size_t)b * 2048 + tq;
    const int NT = 4 * qt + 4, wlast = 4 * qt + (wid >> 1);
    const char* kptr[NKI]; unsigned kstr[NKI]; const char* vptr[2];
    const char* Kbase = (const char*)(ws + (TYPE == 0 ? WS_KAN : TYPE == 1 ? WS_KB : WS_KC));
#pragma unroll
    for (int i = 0; i < NKI; ++i) { const int p = (wid * NKI + i) * 64 + lane;
        if (TYPE == 0) { const int rho = p / 24, cp = p - rho * 24, c = (cp & ~7) | ((cp & 7) ^ ((rho >> 1) & 7));
            if (c < 16) { kptr[i] = Kbase + ((size_t)(b * 2048 + rho) * 1024 + h * 128) * 2 + c * 16; kstr[i] = 131072u; }
            else { kptr[i] = (const char*)(ws + WS_KR) + (size_t)(b * 2048 + rho) * 128 + (c - 16) * 16; kstr[i] = 8192u; }
        } else { const int rho = p >> 4, c = (p & 15) ^ (rho & 15); kptr[i] = Kbase + ((size_t)(b * 2048 + rho) * 1024 + h * 128) * 2 + c * 16; kstr[i] = 131072u; } }
    const char* Vbase = (const char*)(ws + (TYPE == 0 ? WS_VAT : TYPE == 1 ? WS_VBT : WS_VCT));
#pragma unroll
    for (int i = 0; i < 2; ++i) { const int p = (wid * 2 + i) * 64 + lane, r = p >> 3, c = (p & 7) ^ ((r >> 1) & 7); vptr[i] = Vbase + ((size_t)(bh * 128 + r) * 2048) * 2 + c * 16; }
    const char* fptr = (const char*)(ws + WS_FC) + ((size_t)bh * 2048 + lane) * 4;
#define AT_ISSUE(kt, so) do { \
        _Pragma("unroll") for (int i_ = 0; i_ < NKI; ++i_) __builtin_amdgcn_global_load_lds((const unsigned*)(kptr[i_] + (size_t)(kt) * kstr[i_]), (LAS unsigned*)(lds + (so) + (wid * NKI + i_) * 1024), 16, 0, 0); \
        _Pragma("unroll") for (int i_ = 0; i_ < 2; ++i_) __builtin_amdgcn_global_load_lds((const unsigned*)(vptr[i_] + (size_t)(kt) * 128), (LAS unsigned*)(lds + (so) + KREG + (wid * 2 + i_) * 1024), 16, 0, 0); \
        if (TYPE == 1) __builtin_amdgcn_global_load_lds((const unsigned*)(fptr + (size_t)(kt) * 256), (LAS unsigned*)(lds + (so) + KREG + VREG + wid * 256), 4, 0, 0); } while (0)
#define AT_TILE(it_) (TYPE == 2 ? NT - 1 - (it_) : (it_))
    float m_run = -1e30f, l_run = 0.f, carry = 0.f;
    f32x16 o0, o1, o2, o3;
#pragma unroll
    for (int i = 0; i < 16; ++i) { o0[i] = 0.f; o1[i] = 0.f; o2[i] = 0.f; o3[i] = 0.f; }
    const int pl = (l32 & ~12) | ((l32 & 4) << 1) | ((l32 & 8) >> 1);
    const unsigned a0k = (unsigned)(pl * KROWB + ((((TYPE == 0) ? ((pl >> 1) & 7) : (pl & 15)) ^ hh) << 4));
    const unsigned a0v = (unsigned)(KREG + l32 * 128 + ((((l32 >> 1) & 7) ^ hh) << 4));
    const bool ahead = false; bool have_s = false; bool wv_done = false;
    f32x16 s0, s1;
#define AT_KADDR(ks) ((TYPE == 0) ? ((kb_ ^ (unsigned)(32 * ((ks) & 3))) + (unsigned)(((ks) >> 2) * 128)) : (kb_ ^ (unsigned)(32 * (ks))))
#define AT_RK(c) do { _Pragma("unroll") for (int ks = CH * (c); ks < CH * (c) + CH; ++ks) { const unsigned ka = AT_KADDR(ks); kfa[ks] = *(const LAS bf16x8*)(lds + ka); kfb[ks] = *(const LAS bf16x8*)(lds + ka + 32 * KROWB); } } while (0)
#define AT_MK(c) do { _Pragma("unroll") for (int ks = CH * (c); ks < CH * (c) + CH; ++ks) { s0 = MFMA32(kfa[ks], qf[ks], s0); s1 = MFMA32(kfb[ks], qf[ks], s1); } } while (0)
    constexpr int CH = (KS == 12) ? 3 : 4, NC = KS / CH;
#define AT_QK(so_) do { \
        _Pragma("unroll") for (int i_ = 0; i_ < 16; ++i_) { s0[i_] = 0.f; s1[i_] = 0.f; } \
        const unsigned kb_ = a0k + (so_); bf16x8 kfa[KS], kfb[KS]; \
        AT_RK(0); \
        _Pragma("unroll") for (int c_ = 0; c_ < NC; ++c_) { if (c_ + 1 < NC) { AT_RK(c_ + 1); } __builtin_amdgcn_sched_barrier(0); AT_MK(c_); __builtin_amdgcn_sched_barrier(0); } \
          \
        asm volatile("s_nop 7\n\ts_nop 7\n\ts_nop 3" : "+v"(s0), "+v"(s1)); } while (0)
    at_waitv<0>(); AT_BAR();
    AT_ISSUE(AT_TILE(0), 0); AT_ISSUE(AT_TILE(1), SLOT);
    bf16x8 qf[KS];
    if (TYPE == 0) {
        const bf16_t* qn = (const bf16_t*)(ws + WS_QAN) + tokq * 1024 + h * 128 + hh * 8; const bf16_t* qr = (const bf16_t*)(ws + WS_QAR) + tokq * 512 + h * 64 + hh * 8;
#pragma unroll
        for (int ks = 0; ks < 8; ++ks) qf[ks] = *(const bf16x8*)(qn + ks * 16);
#pragma unroll
        for (int ks = 8; ks < KS; ++ks) qf[ks] = *(const bf16x8*)(qr + (ks - 8) * 16);
    } else {
        const bf16_t* qp = (const bf16_t*)(ws + (TYPE == 1 ? WS_QB : WS_QC)) + tokq * 1024 + h * 128 + hh * 8;
#pragma unroll
        for (int ks = 0; ks < KS; ++ks) qf[ks] = *(const bf16x8*)(qp + ks * 16);
    }
#pragma unroll
    for (int ks = 0; ks < KS; ++ks) asm volatile("" : "+v"(qf[ks]));
    unsigned so = 0, so2 = 2 * SLOT;
    for (int it = 0; it < NT; ++it) {
        const int kt = AT_TILE(it);
        if (it + 1 < NT) at_waitv<NI>(); else at_waitv<0>();
        AT_BAR();
        if (TYPE == 2 && it > 0) { const LAS int* fl = (const LAS int*)(lds + FLAGS + ((it - 1) & 1) * 32);
            if (fl[0] & fl[1] & fl[2] & fl[3] & fl[4] & fl[5] & fl[6] & fl[7]) break; }
        if (it + 2 < NT) AT_ISSUE(AT_TILE(it + 2), so2);
        if (kt <= wlast && !(TYPE == 2 && wv_done)) {
            if (!have_s) { AT_QK(so); }
            const unsigned vb = a0v + so;
            bf16x8 vf0[4], vf1[4], vf2[4], vf3[4];
#define AT_RV(vf, mb) do { vf[0] = *(const LAS bf16x8*)(lds + vb + (mb) * 4096); vf[1] = *(const LAS bf16x8*)(lds + (vb ^ 32u) + (mb) * 4096); \
                vf[2] = *(const LAS bf16x8*)(lds + (vb ^ 64u) + (mb) * 4096); vf[3] = *(const LAS bf16x8*)(lds + (vb ^ 96u) + (mb) * 4096); } while (0)
            AT_RV(vf0, 0);
            __builtin_amdgcn_sched_barrier(0);
            const bool diag = (kt == wlast);
            const int key0 = kt * 64 + 8 * hh;
            if (TYPE == 2) {
                if (diag) {
#pragma unroll
                    for (int i = 0; i < 16; ++i) { const int key = key0 + 16 * (i >> 3) + (i & 7); if (key >= tq) s0[i] = -1e30f; if (key + 32 >= tq) s1[i] = -1e30f; } }
                sb_sub(s1, carry, hh); sb_sub(s0, carry, hh);
            } else {
                if (TYPE == 1) { const LAS float* fb = (const LAS float*)(lds + so + KREG + VREG + wid * 256) + 8 * hh;
#pragma unroll
                    for (int j = 0; j < 8; ++j) {
                        const f32x2 b0 = *(const LAS f32x2*)(fb + 16 * (j >> 2) + 2 * (j & 3)), b1 = *(const LAS f32x2*)(fb + 32 + 16 * (j >> 2) + 2 * (j & 3));
                        const f32x2 x0 = pk_sub((f32x2){s0[2 * j], s0[2 * j + 1]}, b0), x1 = pk_sub((f32x2){s1[2 * j], s1[2 * j + 1]}, b1);
                        s0[2 * j] = x0[0]; s0[2 * j + 1] = x0[1]; s1[2 * j] = x1[0]; s1[2 * j + 1] = x1[1]; }
                    if (diag) {
#pragma unroll
                        for (int i = 0; i < 16; ++i) { const int key = key0 + 16 * (i >> 3) + (i & 7); if (key > tq) s0[i] = -1e30f; if (key + 32 > tq) s1[i] = -1e30f; } } }
                float mx = m_run;
#pragma unroll
                for (int i = 0; i < 16; ++i) mx = max3_(mx, s0[i], s1[i]);
                asm volatile("s_nop 1" : "+v"(mx));
                const float mnew = swap_max(mx);
                const f32x2 mm = {mnew, mnew}; f32x2 rs2 = {0.f, 0.f};
#pragma unroll
                for (int j = 0; j < 8; ++j) { const f32x2 x0 = pk_sub((f32x2){s0[2 * j], s0[2 * j + 1]}, mm), x1 = pk_sub((f32x2){s1[2 * j], s1[2 * j + 1]}, mm);
                    s0[2 * j] = exp2_(x0[0]); s0[2 * j + 1] = exp2_(x0[1]); s1[2 * j] = exp2_(x1[0]); s1[2 * j + 1] = exp2_(x1[1]);
                    rs2 += (f32x2){s0[2 * j], s0[2 * j + 1]} + (f32x2){s1[2 * j], s1[2 * j + 1]}; }
                const float rs = rs2[0] + rs2[1];
                if (__any(mnew > m_run)) {
                    const float alpha = exp2_(m_run - mnew);
                    l_run *= alpha; o0 *= alpha; o1 *= alpha; o2 *= alpha; o3 *= alpha;
                }
                l_run += rs; m_run = mnew;
            }
            const bf16x8 p00 = pack8(s0, 0), p01 = pack8(s0, 1), p10 = pack8(s1, 0), p11 = pack8(s1, 1);
#define AT_PV(o, vf) do { o = MFMA32(vf[0], p00, o); o = MFMA32(vf[1], p01, o); o = MFMA32(vf[2], p10, o); o = MFMA32(vf[3], p11, o); } while (0)
            __builtin_amdgcn_sched_barrier(0);
            AT_RV(vf1, 1); AT_PV(o0, vf0); __builtin_amdgcn_sched_barrier(0);
            AT_RV(vf2, 2); AT_PV(o1, vf1); __builtin_amdgcn_sched_barrier(0);
            AT_RV(vf3, 3); AT_PV(o2, vf2); __builtin_amdgcn_sched_barrier(0);
            AT_PV(o3, vf3); __builtin_amdgcn_sched_barrier(0);
#undef AT_PV
#undef AT_RV
        }
        if (TYPE == 2) { wv_done = wv_done || ((kt <= wlast) && __all(carry < -140.f)); if (lane == 0) *(LAS int*)(lds + FLAGS + (it & 1) * 32 + wid * 4) = wv_done ? 1 : 0; }
        so = (so == 2 * SLOT) ? 0u : so + SLOT; so2 = (so2 == 2 * SLOT) ? 0u : so2 + SLOT;
        have_s = false;
        if (ahead && it + 1 < NT && AT_TILE(it + 1) <= wlast) { AT_QK(so); have_s = true; }
    }
#undef AT_ISSUE
#undef AT_TILE
#undef AT_QK
#undef AT_RK
#undef AT_MK
#undef AT_KADDR
    float inv = 1.f;
    if (TYPE != 2) inv = 1.f / swap_sum(l_run);
    at_waitv<0>(); AT_BAR();
    {
        const unsigned ob = (unsigned)(wid * 8704 + l32 * 272 + 8 * hh);
#define AT_OUT(o, mb) do { _Pragma("unroll") for (int g = 0; g < 4; ++g) { u32x2 w; w.x = pk2(o[4 * g] * inv, o[4 * g + 1] * inv); w.y = pk2(o[4 * g + 2] * inv, o[4 * g + 3] * inv); \
            *(LAS u32x2*)(lds + ob + (mb) * 64 + g * 16) = w; } } while (0)
        AT_OUT(o0, 0); AT_OUT(o1, 1); AT_OUT(o2, 2); AT_OUT(o3, 3);
#undef AT_OUT
        const size_t tok0 = (size_t)b * 2048 + qt * 256 + wid * 32;
        const bf16_t* sg = (const bf16_t*)(ws + WS_SG) + (size_t)TYPE * T * 1024 + tok0 * 1024 + h * 128;
        bf16_t* ys = (bf16_t*)(ws + WS_YS) + (size_t)TYPE * T * 1024 + tok0 * 1024 + h * 128;
        u32x4 gv[8];
#pragma unroll
        for (int i = 0; i < 8; ++i) { const int c = lane + 64 * i, r = c >> 4, cc = c & 15; gv[i] = *(const u32x4*)(sg + (size_t)r * 1024 + cc * 8); }
#pragma unroll
        for (int i = 0; i < 8; ++i) { const int c = lane + 64 * i, r = c >> 4, cc = c & 15;
            const u32x4 ov = *(const LAS u32x4*)(lds + wid * 8704 + r * 272 + cc * 16); u32x4 w;
            w.x = pk2(__uint_as_float(ov.x << 16) * __uint_as_float(gv[i].x << 16), __uint_as_float(ov.x & 0xffff0000u) * __uint_as_float(gv[i].x & 0xffff0000u));
            w.y = pk2(__uint_as_float(ov.y << 16) * __uint_as_float(gv[i].y << 16), __uint_as_float(ov.y & 0xffff0000u) * __uint_as_float(gv[i].y & 0xffff0000u));
            w.z = pk2(__uint_as_float(ov.z << 16) * __uint_as_float(gv[i].z << 16), __uint_as_float(ov.z & 0xffff0000u) * __uint_as_float(gv[i].z & 0xffff0000u));
            w.w = pk2(__uint_as_float(ov.w << 16) * __uint_as_float(gv[i].w << 16), __uint_as_float(ov.w & 0xffff0000u) * __uint_as_float(gv[i].w & 0xffff0000u));
            *(u32x4*)(ys + (size_t)r * 1024 + cc * 8) = w; }
    }
}

__device__ __forceinline__ void attn_run(const Params& P, int type, int bh, int qt, LAS unsigned char* lds) {
    const int b = bh >> 3, h = bh & 7;
#ifndef ATT_MASK
#define ATT_MASK 7
#endif
    if ((ATT_MASK & 1) && type == 0) attn_item<0>(P, b, h, qt, lds); else if ((ATT_MASK & 2) && type == 1) attn_item<1>(P, b, h, qt, lds); else if ((ATT_MASK & 4) && type == 2) attn_item<2>(P, b, h, qt, lds);
}
__device__ __forceinline__ void phase_attn(const Params& P, LAS unsigned char* lds) {
    const int G = my_G(), c = my_bx();
    if (G == 256) {
        const int x = c & 7, j = c >> 3, bh = 4 * x + (j >> 3), k = j & 7;
        const int kf = (k == 7) ? 1 : (k == 6) ? 0 : 7 - k;
#pragma unroll 1
        for (int r = 0; r < 3; ++r) attn_run(P, r, bh, r == 0 ? k : r == 1 ? kf : 7 - k, lds);
    } else {
#pragma unroll 1
        for (int idx = c; idx < 768; idx += G) { const int qt = 7 - idx / 96, r = idx % 96; attn_run(P, r >> 5, r & 31, qt, lds); }
    }
    asm volatile("s_waitcnt vmcnt(0)" ::: "memory"); __syncthreads();
}

#define XB_TMO      128
#define XB_XCNT(j)  (256  + 64 * (j))
#define XB_XSUB(j)  (1280 + 64 * (j))
#define XB_XGEN(j)  (2304 + 64 * (j))
#define XB_TOP      3328
#define XB_TOPGEN   3392
#define XCD_BAR_WORDS 3456
#define XB_SPIN_CAP (1u << 18)
__device__ __forceinline__ unsigned xb_ld(unsigned* p)              { return __hip_atomic_load(p, __ATOMIC_RELAXED, __HIP_MEMORY_SCOPE_AGENT); }
__device__ __forceinline__ unsigned xb_add(unsigned* p, unsigned v) { return __hip_atomic_fetch_add(p, v, __ATOMIC_RELAXED, __HIP_MEMORY_SCOPE_AGENT); }
__device__ __forceinline__ unsigned xb_xcc_id() { return (unsigned)__builtin_amdgcn_s_getreg((3 << 11) | 20) & 0xFu; }
#define XB_SPIN(cond, bar) do { unsigned _sp = 0; while (cond) { __builtin_amdgcn_s_sleep(1); \
    if ((++_sp & 255u) == 0u) { if (xb_ld(&(bar)[XB_TMO])) break; if (_sp > XB_SPIN_CAP) { atomicAdd(&(bar)[XB_TMO], 1u); break; } } } } while (0)
struct XcdBarrier { unsigned* bar; unsigned x; volatile LAS unsigned* st; };
__device__ __forceinline__ XcdBarrier xcd_barrier_post(unsigned* bar, volatile LAS unsigned* st) {
    XcdBarrier b; b.bar = bar; b.x = xb_xcc_id(); b.st = st;
    if (threadIdx.x == 0) (void)xb_add(&bar[XB_XCNT(b.x)], 1u);
    return b;
}
__device__ __forceinline__ void xcd_barrier_complete(unsigned* bar, unsigned x, unsigned& nloc, unsigned& nx) {
    const unsigned G = gridDim.x * gridDim.y * gridDim.z;
    unsigned sum, cnt, mine, sp = 0u;
    for (;;) {
        sum = 0u; cnt = 0u; mine = 0u;
#pragma unroll
        for (unsigned j = 0; j < 16; ++j) { const unsigned c = xb_ld(&bar[XB_XCNT(j)]); sum += c; cnt += (c > 0u) ? 1u : 0u; mine = (j == x) ? c : mine; }
        if (sum == G) break;
        __builtin_amdgcn_s_sleep(1);
        if ((++sp & 255u) == 0u) { if (xb_ld(&bar[XB_TMO])) break; if (sp > XB_SPIN_CAP) { atomicAdd(&bar[XB_TMO], 1u); break; } }
    }
    nloc = mine > 0u ? mine : 1u; nx = cnt > 0u ? cnt : 1u;
}
__device__ __forceinline__ void xcd_barrier(const XcdBarrier& b) {
    asm volatile("s_waitcnt vmcnt(0)" ::: "memory");
    __syncthreads();
    if (threadIdx.x == 0) {
        unsigned* bar = b.bar;
        __builtin_amdgcn_s_waitcnt(0);
        unsigned nloc = b.st[0], nx = b.st[1];
        if (nloc == 0u) { xcd_barrier_complete(bar, b.x, nloc, nx); b.st[0] = nloc; b.st[1] = nx; }
        const unsigned old = xb_add(&bar[XB_XSUB(b.x)], 1u);
        const unsigned gen = old / nloc;
        if (old + 1u == (gen + 1u) * nloc) {
            __builtin_amdgcn_fence(__ATOMIC_RELEASE, "agent");
            asm volatile("s_waitcnt vmcnt(0)" ::: "memory");
            const unsigned og = xb_add(&bar[XB_TOP], 1u);
            const unsigned tg = og / nx;
            if (og + 1u == (tg + 1u) * nx) xb_add(&bar[XB_TOPGEN], 1u);
            else XB_SPIN(xb_ld(&bar[XB_TOPGEN]) == tg, bar);
            __builtin_amdgcn_fence(__ATOMIC_ACQUIRE, "agent");
            xb_add(&bar[XB_XGEN(b.x)], 1u);
            asm volatile("s_waitcnt vmcnt(0)" ::: "memory");
        } else {
            XB_SPIN(xb_ld(&bar[XB_XGEN(b.x)]) == gen, bar);
            __builtin_amdgcn_fence(__ATOMIC_ACQUIRE, "agent");
            asm volatile("s_waitcnt vmcnt(0)" ::: "memory");
        }
    }
    __syncthreads();
}

constexpr int N_PHASES = 2 + 6 * NLAYER;
__global__ void __launch_bounds__(512, 2) mega(Params P0) {
    extern __shared__ __attribute__((aligned(16))) unsigned char smem[];
    LAS unsigned char* lds = (LAS unsigned char*)smem;
    cg::grid_group grid = cg::this_grid();
    const int lo = P0.ph_lo, hi = P0.ph_hi;
    volatile LAS unsigned* xst = (volatile LAS unsigned*)(lds + 131072 + 16);
    if (threadIdx.x == 0) { xst[0] = 0u; xst[1] = 0u; }
    __syncthreads();
    const XcdBarrier xbar = xcd_barrier_post((unsigned*)(P0.ws + WS_BAR), xst);
#ifndef PH_MASK
#define PH_MASK 0xff
#endif
#ifndef DUP_MASK
#define DUP_MASK 0
#endif
#ifndef EXTRA_SYNC
#define EXTRA_SYNC 0
#endif
#define NDUP(bit) ((DUP_MASK & (bit)) ? 2 : 1)
#define IN(k) (lo <= (k) && (k) < hi)
#define SEAM(k) do { if (IN(k) && IN((k) + 1)) { if ((k) == 0) grid.sync(); else xcd_barrier(xbar); if (EXTRA_SYNC) xcd_barrier(xbar); } } while (0)
#define FRESH() Params P = P0; { unsigned char* w_ = P0.ws; asm volatile("" : "+s"(w_)); P.ws = w_; } unsigned char* ws = P.ws; (void)ws; const int G = my_G(), bx = my_bx(); (void)G; (void)bx
    if ((PH_MASK & 1) && IN(0)) { for (int d = 0; d < NDUP(1); ++d) { FRESH(); phase_prologue(P, lds, d); if (d + 1 < NDUP(1)) grid.sync(); } SEAM(0); }
#pragma unroll 1
    for (int l = 0; l < NLAYER; ++l) {
        const int p0 = 1 + 6 * l;
        if ((PH_MASK & 2) && IN(p0)) { FRESH(); phase_ln(P, l); SEAM(p0); }
        if ((PH_MASK & 4) && IN(p0 + 1)) {
            FRESH(); unsigned char* wl = ws + WS_W + (size_t)l * SZ_WL;
            __syncthreads();
            pg8::Gemm g{(const bf16_t*)(ws + WS_U), (const bf16_t*)wl, T, N1, DM}; pg8::StaticOrder S; S.init(T, N1, G, bx);
            Epi1 E{ws};
            for (int d = 0; d < NDUP(4); ++d) { pg8::gemm_phase<Epi1, pg8::StaticOrder, true, true>(lds, g, S, E); if (d + 1 < NDUP(4)) grid.sync(); }
            SEAM(p0 + 1);
        }
        if ((PH_MASK & 8) && IN(p0 + 2)) {
            { FRESH(); phase_small(P, l); }
            __syncthreads();
            { FRESH(); unsigned char* wl = ws + WS_W + (size_t)l * SZ_WL;
              pg8::Gemm g{(const bf16_t*)(ws + WS_CQ), (const bf16_t*)(wl + OFF_BT2Q), T, 1536, 512}; pg8::StaticOrder S; S.init(T, 1536, G, bx);
              Epi2<0> E{ws}; pg8::gemm_phase<Epi2<0>, pg8::StaticOrder, false, true>(lds, g, S, E); }
            __syncthreads();
            { FRESH(); unsigned char* wl = ws + WS_W + (size_t)l * SZ_WL;
              pg8::Gemm g{(const bf16_t*)(ws + WS_CKV), (const bf16_t*)(wl + OFF_BT2KV), T, 2048, 256}; pg8::StaticOrder S; S.init(T, 2048, G, bx);
              Epi2<1> E{ws}; pg8::gemm_phase<Epi2<1>, pg8::StaticOrder, false, true>(lds, g, S, E); }
            SEAM(p0 + 2);
        }
        if ((PH_MASK & 16) && IN(p0 + 3)) { for (int d = 0; d < NDUP(16); ++d) { FRESH(); phase_attn(P, lds); if (d + 1 < NDUP(16)) grid.sync(); } SEAM(p0 + 3); }
        if ((PH_MASK & 32) && IN(p0 + 4)) {
            FRESH(); unsigned char* wl = ws + WS_W + (size_t)l * SZ_WL;
            __syncthreads();
            pg8::Gemm g{(const bf16_t*)(ws + WS_YS), (const bf16_t*)(wl + OFF_BT3), 3 * T, 3 * 2048, 1024}; pg8::BranchOrder S; S.so.init(T, 2048, G, bx);
            Epi3 E{ws};
            pg8::gemm_phase<Epi3, pg8::BranchOrder, true, true>(lds, g, S, E);
            SEAM(p0 + 4);
        }
        if ((PH_MASK & 64) && IN(p0 + 5)) {
            FRESH(); unsigned char* wl = ws + WS_W + (size_t)l * SZ_WL;
            __syncthreads();
            pg8::Gemm g{(const bf16_t*)(ws + WS_MRG), (const bf16_t*)(wl + OFF_BT4), T, 2048, 2048}; pg8::StaticOrder S; S.init(T, 2048, G, bx);
            Epi4 E{(bf16_t*)(ws + WS_MRG2)};
            pg8::gemm_phase<Epi4, pg8::StaticOrder, false, true>(lds, g, S, E);
            SEAM(p0 + 5);
        }
    }
    if ((PH_MASK & 2) && IN(N_PHASES - 1)) { FRESH(); phase_ln(P, 4); }
#undef IN
#undef SEAM
#undef FRESH
}

extern "C" void kernel_launch(void* const* d_in, const int* in_sizes, int n_in, void* d_out, int out_size, void* d_ws, size_t ws_size, hipStream_t stream) {
    static int grid = 0;
    if (grid == 0) {
        if (n_in != 15 || ws_size < WS_END) { fprintf(stderr, "kernel_launch: bad inputs (n_in %d, ws %zu < %zu)\n", n_in, ws_size, (size_t)WS_END); grid = -1; return; }
        int dev = 0, cus = 0, per_cu = 0;
        hipGetDevice(&dev); hipDeviceGetAttribute(&cus, hipDeviceAttributeMultiprocessorCount, dev);
        if (hipFuncSetAttribute((const void*)mega, hipFuncAttributeMaxDynamicSharedMemorySize, LDS_BYTES) != hipSuccess) { fprintf(stderr, "kernel_launch: hipFuncSetAttribute failed\n"); grid = -1; return; }
        if (hipOccupancyMaxActiveBlocksPerMultiprocessor(&per_cu, (const void*)mega, 512, LDS_BYTES) != hipSuccess || per_cu < 1) { fprintf(stderr, "kernel_launch: occupancy query says %d\n", per_cu); per_cu = 1; }
        (void)hipGetLastError();
        grid = cus * per_cu;
    }
    if (grid < 0) return;
    (void)hipMemsetAsync((char*)d_ws + WS_CTR, 0, WS_ZERO_BYTES, stream);
    Params p{};
    p.x = (const float*)d_in[0]; p.c = (const float*)d_in[1]; p.pos = (const int*)d_in[2]; p.w_ada = (const float*)d_in[3]; p.b_ada = (const float*)d_in[4]; p.w_in = (const float*)d_in[5];
    p.qng = (const float*)d_in[6]; p.kvng = (const float*)d_in[7]; p.w_uq = (const float*)d_in[8]; p.w_ukv = (const float*)d_in[9]; p.fox_bias = (const float*)d_in[10];
    p.w_branch = (const float*)d_in[11]; p.w_out = (const float*)d_in[12]; p.ln_g = (const float*)d_in[13]; p.ln_b = (const float*)d_in[14];
    p.out = (float*)d_out; p.ws = (unsigned char*)d_ws;
#if PER_PHASE_LAUNCH
    for (int ph = 0; ph < N_PHASES; ++ph) { p.ph_lo = ph; p.ph_hi = ph + 1; hipLaunchKernelGGL(mega, dim3(grid), dim3(512), LDS_BYTES, stream, p); }
#else
    p.ph_lo = 0; p.ph_hi = N_PHASES;
    void* args[] = {&p};
    hipError_t e = hipLaunchCooperativeKernel((const void*)mega, dim3(grid), dim3(512), args, LDS_BYTES, stream);
    if (e != hipSuccess) fprintf(stderr, "kernel_launch: cooperative launch failed: %s (grid %d)\n", hipGetErrorString(e), grid);
#endif
}
```

```cpp
#include <hip/hip_runtime.h>
#include <hip/hip_cooperative_groups.h>
#include <cstdio>
#include <cstdint>
#include <cmath>
namespace cg = cooperative_groups;

#ifndef PER_PHASE_LAUNCH
#define PER_PHASE_LAUNCH 0
#endif

#define LAS __attribute__((address_space(3)))
typedef unsigned short bf16_t;
typedef short bf16x8 __attribute__((ext_vector_type(8)));
typedef float f32x4 __attribute__((ext_vector_type(4)));
typedef float f32x2 __attribute__((ext_vector_type(2)));
typedef float f32x16 __attribute__((ext_vector_type(16)));
typedef unsigned u32x4 __attribute__((ext_vector_type(4)));
typedef unsigned u32x2 __attribute__((ext_vector_type(2)));
typedef __bf16 bf16x2_t __attribute__((ext_vector_type(2)));

constexpr int T = 8192, DM = 2048, SEQ = 2048, NBATCH = 4, NLAYER = 4, DIN = 16200, N1 = 16384;
constexpr float LOG2E = 1.4426950408889634f;
constexpr float ALPHA = 1.681792830507429f;
constexpr int LDS_BYTES = 131072 + 1024;

constexpr size_t al256(size_t x) { return (x + 255) & ~(size_t)255; }
constexpr size_t SZ_BT1 = (size_t)N1 * DM * 2, SZ_BT2Q = (size_t)1536 * 512 * 2, SZ_BT2KV = (size_t)2048 * 256 * 2, SZ_BT3 = (size_t)3 * 2048 * 1024 * 2, SZ_BT4 = (size_t)2048 * 2048 * 2;
constexpr size_t OFF_BT2Q = SZ_BT1, OFF_BT2KV = OFF_BT2Q + SZ_BT2Q, OFF_BT3 = OFF_BT2KV + SZ_BT2KV, OFF_BT4 = OFF_BT3 + SZ_BT3, SZ_WL = OFF_BT4 + SZ_BT4;
constexpr size_t WS_CTR = 0;
constexpr size_t WS_BAR = 256;
constexpr size_t WS_ZERO_BYTES = 256 + 16384;
constexpr size_t WS_W = WS_ZERO_BYTES;
constexpr size_t WS_MOD = al256(WS_W + NLAYER * SZ_WL);
constexpr size_t WS_CS = al256(WS_MOD + (size_t)NLAYER * 4 * 6144 * 4);
constexpr size_t WS_U = al256(WS_CS + (size_t)T * 32 * 8);
constexpr size_t WS_X = al256(WS_U + (size_t)T * DM * 2);
constexpr size_t WS_Y = al256(WS_X + (size_t)T * DM * 4);
constexpr size_t WS_MRG2 = WS_Y;
constexpr size_t WS_CQ = al256(WS_Y + (size_t)T * DM * 4);
constexpr size_t WS_CKV = al256(WS_CQ + (size_t)T * 512 * 2);
constexpr size_t WS_SSQ = al256(WS_CKV + (size_t)T * 256 * 2);
constexpr size_t WS_SG = al256(WS_SSQ + (size_t)T * 16 * 4);
constexpr size_t SZ_TH = (size_t)T * 1024 * 2;
constexpr size_t WS_QB = al256(WS_SG + 3 * SZ_TH), WS_KB = WS_QB + SZ_TH, WS_VBT = WS_KB + SZ_TH, WS_QC = WS_VBT + SZ_TH, WS_KC = WS_QC + SZ_TH, WS_VCT = WS_KC + SZ_TH;
constexpr size_t WS_QAN = WS_VCT + SZ_TH, WS_KAN = WS_QAN + SZ_TH, WS_VAT = WS_KAN + SZ_TH;
constexpr size_t WS_QAR = WS_VAT + SZ_TH;
constexpr size_t WS_KR = al256(WS_QAR + (size_t)T * 512 * 2);
constexpr size_t WS_MISC = al256(WS_KR + (size_t)T * 64 * 2);
constexpr size_t WS_FC = al256(WS_MISC + (size_t)T * 128 * 4);
constexpr size_t WS_MG = al256(WS_FC + (size_t)32 * 2048 * 4);
constexpr size_t WS_YS = al256(WS_MG + (size_t)T * 6144 * 2);
constexpr size_t WS_MACC = al256(WS_YS + 3 * SZ_TH);
constexpr size_t WS_MRG = al256(WS_MACC + (size_t)T * DM * 4);
constexpr size_t WS_END = al256(WS_MRG + (size_t)T * DM * 2);

struct Params {
    const float* x; const float* c; const int* pos; const float* w_ada; const float* b_ada; const float* w_in;
    const float* qng; const float* kvng; const float* w_uq; const float* w_ukv; const float* fox_bias;
    const float* w_branch; const float* w_out; const float* ln_g; const float* ln_b;
    float* out; unsigned char* ws;
    int ph_lo, ph_hi;
};

__device__ __forceinline__ unsigned pk2(float lo, float hi) { f32x2 v = {lo, hi}; bf16x2_t b = __builtin_convertvector(v, bf16x2_t); return __builtin_bit_cast(unsigned, b); }
__device__ __forceinline__ bf16_t f2bf(float x) { return (bf16_t)(pk2(x, 0.f) & 0xffffu); }
__device__ __forceinline__ float bf2f(bf16_t b) { return __uint_as_float(((unsigned)b) << 16); }
__device__ __forceinline__ float wave_sum(float v) {
#pragma unroll
    for (int o = 32; o >= 1; o >>= 1) v += __shfl_xor(v, o);
    return v;
}
__device__ __forceinline__ float sigmoidf_(float x) { return __builtin_amdgcn_rcpf(1.f + __expf(-x)); }
__device__ __forceinline__ float siluf_(float x) { return x * sigmoidf_(x); }
__device__ __forceinline__ float exp2_(float x) { return __builtin_amdgcn_exp2f(x); }
__device__ __forceinline__ float log2_(float x) { return __builtin_amdgcn_logf(x); }
__device__ __forceinline__ float max3_(float a, float b, float c) { float r; asm("v_max3_f32 %0, %1, %2, %3" : "=v"(r) : "v"(a), "v"(b), "v"(c)); return r; }
__device__ __forceinline__ f32x2 pk_sub(f32x2 a, f32x2 b) { f32x2 r; asm("v_pk_add_f32 %0, %1, %2 neg_lo:[0,1] neg_hi:[0,1]" : "=v"(r) : "v"(a), "v"(b)); return r; }
__device__ __forceinline__ f32x2 pk_add(f32x2 a, f32x2 b) { f32x2 r; asm("v_pk_add_f32 %0, %1, %2" : "=v"(r) : "v"(a), "v"(b)); return r; }
__device__ __forceinline__ float swap_max(float x) { auto rr = __builtin_amdgcn_permlane32_swap(__float_as_uint(x), __float_as_uint(x), false, false); return fmaxf(__uint_as_float(rr[0]), __uint_as_float(rr[1])); }
__device__ __forceinline__ float swap_sum(float x) { auto rr = __builtin_amdgcn_permlane32_swap(__float_as_uint(x), __float_as_uint(x), false, false); return __uint_as_float(rr[0]) + __uint_as_float(rr[1]); }
__device__ __forceinline__ float swap_partner(float x, int hh) { auto rr = __builtin_amdgcn_permlane32_swap(__float_as_uint(x), __float_as_uint(x), false, false); return __uint_as_float(hh ? rr[0] : rr[1]); }

__device__ __forceinline__ int my_tid() { int t = threadIdx.x; asm volatile("" : "+v"(t)); return t; }
__device__ __forceinline__ int my_bx() { int b = blockIdx.x; asm volatile("" : "+s"(b)); return b; }
__device__ __forceinline__ int my_G() { int g = gridDim.x; asm volatile("" : "+s"(g)); return g; }
namespace pg8 {
#define PG8_LAS __attribute__((address_space(3)))
constexpr int BM = 256, BK = 64, HALF = 128, HTB = HALF * BK * 2, STAGE_BYTES = 8 * HTB, NXCD = 8, WGM = 8;
__host__ __device__ __forceinline__ int lds_byte(int r, int c) { const int st = (r >> 4) * 2 + (c >> 5), rr = r & 15, cc = c & 31, ob = rr * 64 + cc * 2; return st * 1024 + (ob ^ (((ob >> 9) & 1) << 5)); }
__host__ __device__ __forceinline__ void stage_rc(int b, int& R, int& C) { const int st = b / 1024, sb = b % 1024, swz = sb ^ (((sb >> 9) & 1) << 5); R = (st >> 1) * 16 + swz / 64; C = (st & 1) * 32 + (swz % 64) / 2; }
__host__ __device__ __forceinline__ int perm32(int rho) { const int n = rho >> 4, i = rho & 15; return 8 * (i >> 2) + 4 * n + (i & 3); }
struct Unit { int pm, pn; };
struct Gemm { const bf16_t* A; const bf16_t* Bt; int M, N, K; };
struct StaticOrder {
    int nM, nN, nwg, G, c;
    __host__ __device__ void init(int M, int N, int G_, int c_) { nM = M / BM; nN = N / BM; nwg = nM * nN; G = G_; c = c_; }
    __host__ __device__ bool next(int i, Unit& u) const {
        const long L = (long)i * G + c; if (L >= nwg) return false;
        int wgid = (int)L; { const int q = nwg / NXCD, r = nwg % NXCD, xcd = wgid % NXCD, off = wgid / NXCD; wgid = (xcd < r ? xcd * (q + 1) : r * (q + 1) + (xcd - r) * q) + off; }
        const int nig = WGM * nN, gid = wgid / nig, fm = gid * WGM, gsz = (nM - fm) < WGM ? (nM - fm) : WGM;
        u.pm = fm + ((wgid % nig) % gsz); u.pn = (wgid % nig) / gsz; return true;
    }
    __device__ __forceinline__ void a_ready(const Unit&) const {}
    __device__ __forceinline__ void done(const Unit&) const {}
};
struct BranchOrder {
    StaticOrder so;
    __device__ bool next(int i, Unit& u) const { Unit t; if (!so.next(i / 3, t)) return false; const int n = i % 3; u.pm = n * 32 + t.pm; u.pn = n * 8 + t.pn; return true; }
    __device__ __forceinline__ void a_ready(const Unit&) const {}
    __device__ __forceinline__ void done(const Unit&) const {}
};

template <class Epi, class Sched, bool ALIGN_EPI = false, bool SP2 = false>
__device__ __forceinline__ void gemm_phase(PG8_LAS unsigned char* lds, const Gemm g, const Sched& S, const Epi& E) {
    const int tid = my_tid(), wid = __builtin_amdgcn_readfirstlane(tid >> 6), lane = tid & 63, wr = wid >> 2, wc = wid & 3, fr = lane & 15, fq = lane >> 4;
    const int K = g.K, nt = K / BK;
    unsigned voffA[2], voffB[2];
#pragma unroll
    for (int i = 0; i < 2; ++i) { int R, C; stage_rc(tid * 16 + i * 8192, R, C); const int Rb = Epi::PERM ? ((R & ~31) + perm32(R & 31)) : R;
        voffA[i] = (unsigned)(R * K + C) * 2u; voffB[i] = (unsigned)(Rb * K + C) * 2u; }
    const size_t kstep = (size_t)(BK * 2);
    const size_t hstep = (size_t)HALF * K * 2;
    const size_t tstep = 2 * hstep;
    const unsigned ldsw = (unsigned)wid * 1024u;
    const int aoff = lds_byte(wr * 64 + fr, fq * 8), boff = lds_byte(wc * 32 + fr, fq * 8);
#define PG8_SA(b, h) (((b) * 2 + (h)) * HTB)
#define PG8_SB(b, h) ((4 + (b) * 2 + (h)) * HTB)
#define PG8_STAGE(bufoff, gbase, voff) do { _Pragma("unroll") for (int _i = 0; _i < 2; ++_i) \
        __builtin_amdgcn_global_load_lds((const unsigned*)((const char*)(gbase) + (voff)[_i]), (PG8_LAS unsigned*)(lds + (bufoff) + ldsw + _i * 8192), 16, 0, 0); } while (0)
#define PG8_LDA(dst, b, h) do { _Pragma("unroll") for (int m = 0; m < 4; ++m) _Pragma("unroll") for (int k = 0; k < 2; ++k) dst[m][k] = *(const PG8_LAS bf16x8*)(lds + PG8_SA(b, h) + aoff + m * 2048 + k * 1024); } while (0)
#define PG8_LDB(dst, b, h) do { _Pragma("unroll") for (int n = 0; n < 2; ++n) _Pragma("unroll") for (int k = 0; k < 2; ++k) dst[n][k] = *(const PG8_LAS bf16x8*)(lds + PG8_SB(b, h) + boff + n * 2048 + k * 1024); } while (0)
#define PG8_MMA(ai, bj, At, Bt) do { __builtin_amdgcn_s_setprio(1); _Pragma("unroll") for (int m = 0; m < 4; ++m) _Pragma("unroll") for (int n = 0; n < 2; ++n) _Pragma("unroll") for (int k = 0; k < 2; ++k) \
        acc[ai][bj][m][n] = __builtin_amdgcn_mfma_f32_16x16x32_bf16(Bt[n][k], At[m][k], acc[ai][bj][m][n], 0, 0, 0); __builtin_amdgcn_s_setprio(0); } while (0)
#define PG8_WAIT_V(n) asm volatile("s_waitcnt vmcnt(" #n ")" ::: "memory")
#define PG8_WAIT_L(n) asm volatile("s_waitcnt lgkmcnt(" #n ")" ::: "memory")
#define PG8_BAR __builtin_amdgcn_s_barrier()
#define PG8_SCHED __builtin_amdgcn_sched_barrier(0)
    Unit cur, nxt; int ui = 0;
    if (!S.next(0, cur)) return;
    f32x4 acc[2][2][4][2];
#pragma unroll
    for (int a = 0; a < 2; ++a)
#pragma unroll
        for (int b = 0; b < 2; ++b)
#pragma unroll
            for (int m = 0; m < 4; ++m)
#pragma unroll
                for (int n = 0; n < 2; ++n) acc[a][b][m][n] = (f32x4){0.f, 0.f, 0.f, 0.f};
    bf16x8 At[4][2], B0[2][2], B1[2][2];
    const char* cA = (const char*)g.A + (size_t)cur.pm * tstep; const char* cB = (const char*)g.Bt + (size_t)cur.pn * tstep;
    S.a_ready(cur);
    if constexpr (SP2) {
        PG8_STAGE(PG8_SB(0, 0), cB, voffB); PG8_STAGE(PG8_SB(0, 1), cB + hstep, voffB); PG8_STAGE(PG8_SA(0, 0), cA, voffA); PG8_STAGE(PG8_SA(0, 1), cA + hstep, voffA);
        if (wr == 1) PG8_BAR;
        PG8_WAIT_V(2); PG8_BAR;
        PG8_STAGE(PG8_SB(1, 0), cB + kstep, voffB); PG8_STAGE(PG8_SA(1, 0), cA + kstep, voffA); PG8_STAGE(PG8_SB(1, 1), cB + hstep + kstep, voffB);
        PG8_WAIT_V(6); PG8_BAR;
    } else {
        PG8_STAGE(PG8_SB(0, 0), cB, voffB); PG8_STAGE(PG8_SA(0, 0), cA, voffA); PG8_STAGE(PG8_SB(0, 1), cB + hstep, voffB); PG8_STAGE(PG8_SA(0, 1), cA + hstep, voffA);
        if (wr == 1) PG8_BAR;
        PG8_WAIT_V(4); PG8_BAR;
        PG8_STAGE(PG8_SB(1, 0), cB + kstep, voffB); PG8_STAGE(PG8_SA(1, 0), cA + kstep, voffA); PG8_STAGE(PG8_SB(1, 1), cB + hstep + kstep, voffB);
        PG8_WAIT_V(6); PG8_BAR;
    }
    for (;;) {
        const bool has_next = S.next(ui + 1, nxt);
        const char* nA = has_next ? (const char*)g.A + (size_t)nxt.pm * tstep : cA; const char* nB = has_next ? (const char*)g.Bt + (size_t)nxt.pn * tstep : cB;
#pragma unroll 1
        for (int t = 0; t < nt; t += 2) {
            const bool last = (t == nt - 2);
            const char* a1 = cA + (size_t)(t + 1) * kstep;
            const char* a2 = last ? nA : cA + (size_t)(t + 2) * kstep; const char* b2 = last ? nB : cB + (size_t)(t + 2) * kstep;
            const char* a3 = a2 + kstep; const char* b3 = b2 + kstep;
            if (last && has_next) S.a_ready(nxt);
            if constexpr (SP2) {
            PG8_LDB(B0, 0, 0); PG8_LDB(B1, 0, 1); PG8_SCHED; PG8_LDA(At, 0, 0); PG8_STAGE(PG8_SA(1, 1), a1 + hstep, voffA);
            PG8_WAIT_V(8); PG8_WAIT_L(0); PG8_BAR; PG8_MMA(0, 0, At, B0); PG8_MMA(0, 1, At, B1); PG8_BAR; PG8_SCHED;
            PG8_LDA(At, 0, 1); PG8_STAGE(PG8_SB(0, 0), b2, voffB); PG8_STAGE(PG8_SB(0, 1), b2 + hstep, voffB); PG8_STAGE(PG8_SA(0, 0), a2, voffA);
            PG8_WAIT_V(8); PG8_WAIT_L(0); PG8_BAR; PG8_MMA(1, 0, At, B0); PG8_MMA(1, 1, At, B1); PG8_BAR; PG8_SCHED;
            PG8_LDB(B0, 1, 0); PG8_LDB(B1, 1, 1); PG8_SCHED; PG8_LDA(At, 1, 0); PG8_STAGE(PG8_SA(0, 1), a2 + hstep, voffA);
            PG8_WAIT_V(8); PG8_WAIT_L(0); PG8_BAR; PG8_MMA(0, 0, At, B0); PG8_MMA(0, 1, At, B1); PG8_BAR; PG8_SCHED;
            PG8_LDA(At, 1, 1); PG8_STAGE(PG8_SB(1, 0), b3, voffB); PG8_STAGE(PG8_SB(1, 1), b3 + hstep, voffB); PG8_STAGE(PG8_SA(1, 0), a3, voffA);
            PG8_WAIT_V(8); PG8_WAIT_L(0); PG8_BAR; PG8_MMA(1, 0, At, B0); PG8_MMA(1, 1, At, B1); PG8_BAR; PG8_SCHED;
            } else {
            PG8_LDB(B0, 0, 0); PG8_SCHED; PG8_LDA(At, 0, 0); PG8_STAGE(PG8_SA(1, 1), a1 + hstep, voffA);
            PG8_WAIT_L(8); PG8_BAR; PG8_WAIT_L(0); PG8_MMA(0, 0, At, B0); PG8_BAR; PG8_SCHED;
            PG8_LDB(B1, 0, 1); PG8_STAGE(PG8_SB(0, 0), b2, voffB);
            PG8_BAR; PG8_WAIT_L(0); PG8_MMA(0, 1, At, B1); PG8_BAR;
            PG8_LDA(At, 0, 1); PG8_STAGE(PG8_SA(0, 0), a2, voffA);
            PG8_BAR; PG8_WAIT_L(0); PG8_MMA(1, 0, At, B0); PG8_BAR; PG8_SCHED;
            PG8_STAGE(PG8_SB(0, 1), b2 + hstep, voffB);
            PG8_WAIT_V(6); PG8_BAR; PG8_MMA(1, 1, At, B1); PG8_BAR;
            PG8_LDB(B0, 1, 0); PG8_SCHED; PG8_LDA(At, 1, 0); PG8_STAGE(PG8_SA(0, 1), a2 + hstep, voffA);
            PG8_WAIT_L(8); PG8_BAR; PG8_WAIT_L(0); PG8_MMA(0, 0, At, B0); PG8_BAR; PG8_SCHED;
            PG8_LDB(B1, 1, 1); PG8_STAGE(PG8_SB(1, 0), b3, voffB);
            PG8_BAR; PG8_WAIT_L(0); PG8_MMA(0, 1, At, B1); PG8_BAR;
            PG8_LDA(At, 1, 1); PG8_STAGE(PG8_SA(1, 0), a3, voffA);
            PG8_BAR; PG8_WAIT_L(0); PG8_MMA(1, 0, At, B0); PG8_BAR; PG8_SCHED;
            PG8_STAGE(PG8_SB(1, 1), b3 + hstep, voffB);
            PG8_WAIT_V(6); PG8_BAR; PG8_MMA(1, 1, At, B1); PG8_BAR;
            }
        }
        if constexpr (ALIGN_EPI) { if (wr == 0) PG8_BAR; }
        E(acc, cur, wr, wc, fr, fq); S.done(cur);
        if (!has_next) break;
        if (!E.keep_acc(cur)) {
#pragma unroll
        for (int a = 0; a < 2; ++a)
#pragma unroll
            for (int b = 0; b < 2; ++b)
#pragma unroll
                for (int m = 0; m < 4; ++m)
#pragma unroll
                    for (int n = 0; n < 2; ++n) acc[a][b][m][n] = (f32x4){0.f, 0.f, 0.f, 0.f};
        }
        cur = nxt; cA = nA; cB = nB; ++ui;
        if constexpr (ALIGN_EPI) { if (wr == 1) PG8_BAR; }
    }
    PG8_WAIT_V(0);
    if constexpr (!ALIGN_EPI) { if (wr == 0) PG8_BAR; }
    PG8_BAR;
#undef PG8_SA
#undef PG8_SB
#undef PG8_STAGE
#undef PG8_LDA
#undef PG8_LDB
#undef PG8_MMA
#undef PG8_WAIT_V
#undef PG8_WAIT_L
#undef PG8_BAR
#undef PG8_SCHED
}
}

typedef const f32x4 (&AccRef)[2][2][4][2];
typedef f32x4 (&AccMut)[2][2][4][2];

template <int ACT> __device__ __forceinline__ void store_bf16_tile(AccRef acc, bf16_t* base, int ld, int row0, int cl0) {
#pragma unroll
    for (int ai = 0; ai < 2; ++ai)
#pragma unroll
        for (int m = 0; m < 4; ++m) { bf16_t* rp = base + (size_t)(row0 + ai * 128 + m * 16) * ld + cl0;
#pragma unroll
            for (int bj = 0; bj < 2; ++bj) { f32x4 v0 = acc[ai][bj][m][0], v1 = acc[ai][bj][m][1];
                if (ACT == 1) {
#pragma unroll
                    for (int j = 0; j < 4; ++j) { v0[j] = siluf_(v0[j]); v1[j] = siluf_(v1[j]); } }
                if (ACT == 2) {
#pragma unroll
                    for (int j = 0; j < 4; ++j) { v0[j] = sigmoidf_(v0[j]); v1[j] = sigmoidf_(v1[j]); } }
                u32x4 w; w.x = pk2(v0[0], v0[1]); w.y = pk2(v0[2], v0[3]); w.z = pk2(v1[0], v1[1]); w.w = pk2(v1[2], v1[3]);
                *(u32x4*)(rp + bj * 128) = w; } }
}
__device__ __forceinline__ void store_vt_tile(AccRef acc, bf16_t* VT, int h0, int row0, int cl0, const float* rscale) {
#pragma unroll
    for (int ai = 0; ai < 2; ++ai)
#pragma unroll
        for (int m = 0; m < 4; ++m) { const int row = row0 + ai * 128 + m * 16; const int b = row >> 11, s = row & 2047; const float rs = rscale ? rscale[ai * 4 + m] : 1.f;
#pragma unroll
            for (int bj = 0; bj < 2; ++bj) { const unsigned po = (unsigned)(((b * 8 + h0 + bj) * 128 + cl0) * 2048 + s);
#pragma unroll
                for (int n = 0; n < 2; ++n)
#pragma unroll
                    for (int j = 0; j < 4; ++j) VT[po + (unsigned)((4 * n + j) * 2048)] = f2bf(acc[ai][bj][m][n][j] * rs); }
            asm volatile("" ::: "memory"); }
}

struct Epi1 {
    static constexpr bool PERM = true;
    __device__ __forceinline__ bool keep_acc(const pg8::Unit&) const { return false; }
    unsigned char* ws;
    __device__ __forceinline__ void operator()(AccRef acc, const pg8::Unit& u, int wr, int wc, int fr, int fq) const {
        const int pn = (13 * u.pn) & 63, row0 = u.pm * 256 + wr * 64 + fr, cl0 = wc * 32 + 8 * fq;
        if (pn < 3) {
            bf16_t* base; int ld, slot;
            if (pn < 2) { base = (bf16_t*)(ws + WS_CQ) + pn * 256; ld = 512; slot = pn * 4 + wc; } else { base = (bf16_t*)(ws + WS_CKV); ld = 256; slot = 8 + wc; }
            float* ssq = (float*)(ws + WS_SSQ);
#pragma unroll
            for (int ai = 0; ai < 2; ++ai)
#pragma unroll
                for (int m = 0; m < 4; ++m) { const int row = row0 + ai * 128 + m * 16; bf16_t* rp = base + (size_t)row * ld + cl0; float ss = 0.f;
#pragma unroll
                    for (int bj = 0; bj < 2; ++bj) { const f32x4 v0 = acc[ai][bj][m][0], v1 = acc[ai][bj][m][1];
                        ss += (v0[0] * v0[0] + v0[1] * v0[1]) + (v0[2] * v0[2] + v0[3] * v0[3]) + (v1[0] * v1[0] + v1[1] * v1[1]) + (v1[2] * v1[2] + v1[3] * v1[3]);
                        u32x4 w; w.x = pk2(v0[0], v0[1]); w.y = pk2(v0[2], v0[3]); w.z = pk2(v1[0], v1[1]); w.w = pk2(v1[2], v1[3]);
                        *(u32x4*)(rp + bj * 128) = w; }
                    ss += __shfl_xor(ss, 16); ss += __shfl_xor(ss, 32);
                    if (fq == 0) ssq[(size_t)row * 16 + slot] = ss; }
        } else if (pn == 63) {
            float* misc = (float*)(ws + WS_MISC);
#pragma unroll
            for (int ai = 0; ai < 2; ++ai)
#pragma unroll
                for (int m = 0; m < 4; ++m) { float* rp = misc + (size_t)(row0 + ai * 128 + m * 16) * 128 + cl0;
                    *(f32x4*)(rp) = acc[ai][0][m][0]; *(f32x4*)(rp + 4) = acc[ai][0][m][1]; }
        } else if (pn >= 39) {
            store_bf16_tile<2>(acc, (bf16_t*)(ws + WS_MG) + (pn - 39) * 256, 6144, row0, cl0);
        } else {
            const int seg = (pn - 3) >> 2, ct = (pn - 3) & 3;
            if (seg == 0 || seg == 4 || seg == 8) store_bf16_tile<1>(acc, (bf16_t*)(ws + WS_SG) + (size_t)(seg >> 2) * T * 1024 + ct * 256, 1024, row0, cl0);
            else if (seg == 3) store_vt_tile(acc, (bf16_t*)(ws + WS_VBT), ct * 2, row0, cl0, nullptr);
            else if (seg == 7) store_vt_tile(acc, (bf16_t*)(ws + WS_VCT), ct * 2, row0, cl0, nullptr);
            else { const size_t off = seg == 1 ? WS_QB : seg == 2 ? WS_KB : seg == 5 ? WS_QC : WS_KC; store_bf16_tile<0>(acc, (bf16_t*)(ws + off) + ct * 256, 1024, row0, cl0); }
        }
    }
};

template <int WHICH  > struct Epi2 {
    static constexpr bool PERM = true;
    __device__ __forceinline__ bool keep_acc(const pg8::Unit&) const { return false; }
    unsigned char* ws;
    __device__ __forceinline__ float rstd(int row) const {
        const float* ssq = (const float*)(ws + WS_SSQ) + (size_t)row * 16 + (WHICH ? 8 : 0);
        const f32x4 a = *(const f32x4*)ssq; float s = (a[0] + a[1]) + (a[2] + a[3]);
        if (WHICH == 0) { const f32x4 b = *(const f32x4*)(ssq + 4); s += (b[0] + b[1]) + (b[2] + b[3]); }
        return rsqrtf(s * (WHICH ? (1.f / 256.f) : (1.f / 512.f)) + 1e-6f);
    }
    __device__ __forceinline__ void operator()(AccRef acc, const pg8::Unit& u, int wr, int wc, int fr, int fq) const {
        const int pn = u.pn, row0 = u.pm * 256 + wr * 64 + fr, cl0 = wc * 32 + 8 * fq;
        if (pn < 4) {
            bf16_t* base = (bf16_t*)(ws + (WHICH ? WS_KAN : WS_QAN)) + pn * 256;
#pragma unroll
            for (int ai = 0; ai < 2; ++ai)
#pragma unroll
                for (int m = 0; m < 4; ++m) { const int row = row0 + ai * 128 + m * 16; bf16_t* rp = base + (size_t)row * 1024 + cl0; const float r = rstd(row);
#pragma unroll
                    for (int bj = 0; bj < 2; ++bj) { const f32x4 v0 = acc[ai][bj][m][0] * r, v1 = acc[ai][bj][m][1] * r;
                        u32x4 w; w.x = pk2(v0[0], v0[1]); w.y = pk2(v0[2], v0[3]); w.z = pk2(v1[0], v1[1]); w.w = pk2(v1[2], v1[3]);
                        *(u32x4*)(rp + bj * 128) = w; }
                    asm volatile("" ::: "memory"); }
        } else if (WHICH == 1) {
            bf16_t* VT = (bf16_t*)(ws + WS_VAT); const int h0 = (pn - 4) * 2;
#pragma unroll
            for (int ai = 0; ai < 2; ++ai)
#pragma unroll
                for (int m = 0; m < 4; ++m) { const int row = row0 + ai * 128 + m * 16; const int b = row >> 11, s = row & 2047; const float rs = rstd(row);
#pragma unroll
                    for (int bj = 0; bj < 2; ++bj) { const unsigned po = (unsigned)(((b * 8 + h0 + bj) * 128 + cl0) * 2048 + s);
#pragma unroll
                        for (int n = 0; n < 2; ++n)
#pragma unroll
                            for (int j = 0; j < 4; ++j) VT[po + (unsigned)((4 * n + j) * 2048)] = f2bf(acc[ai][bj][m][n][j] * rs); }
                    asm volatile("" ::: "memory"); }
        } else {
            bf16_t* base = (bf16_t*)(ws + WS_QAR) + (pn - 4) * 256;
            const f32x2* cs = (const f32x2*)(ws + WS_CS);
#pragma unroll
            for (int ai = 0; ai < 2; ++ai)
#pragma unroll
                for (int m = 0; m < 4; ++m) { const int row = row0 + ai * 128 + m * 16; bf16_t* rp = base + (size_t)row * 512 + cl0; const float r = rstd(row);
#pragma unroll
                    for (int bj = 0; bj < 2; ++bj) { const int j0 = ((bj * 128 + cl0) & 63) >> 1;
                        const f32x4 c01 = *(const f32x4*)(cs + (size_t)row * 32 + j0), c23 = *(const f32x4*)(cs + (size_t)row * 32 + j0 + 2);
                        const f32x4 v0 = acc[ai][bj][m][0] * r, v1 = acc[ai][bj][m][1] * r;
                        u32x4 w;
                        w.x = pk2(v0[0] * c01[0] - v0[1] * c01[1], v0[1] * c01[0] + v0[0] * c01[1]);
                        w.y = pk2(v0[2] * c01[2] - v0[3] * c01[3], v0[3] * c01[2] + v0[2] * c01[3]);
                        w.z = pk2(v1[0] * c23[0] - v1[1] * c23[1], v1[1] * c23[0] + v1[0] * c23[1]);
                        w.w = pk2(v1[2] * c23[2] - v1[3] * c23[3], v1[3] * c23[2] + v1[2] * c23[3]);
                        *(u32x4*)(rp + bj * 128) = w; }
                    asm volatile("" ::: "memory"); }
        }
    }
};

__device__ __forceinline__ void unpack_gate(const u32x4 gw, f32x4& g0, f32x4& g1) {
    g0[0] = __uint_as_float(gw.x << 16); g0[1] = __uint_as_float(gw.x & 0xffff0000u); g0[2] = __uint_as_float(gw.y << 16); g0[3] = __uint_as_float(gw.y & 0xffff0000u);
    g1[0] = __uint_as_float(gw.z << 16); g1[1] = __uint_as_float(gw.z & 0xffff0000u); g1[2] = __uint_as_float(gw.w << 16); g1[3] = __uint_as_float(gw.w & 0xffff0000u);
}
struct Epi3 {
    static constexpr bool PERM = true;
    __device__ __forceinline__ bool keep_acc(const pg8::Unit& u) const { return (u.pm >> 5) < 2; }
    unsigned char* ws;
    __device__ __forceinline__ void operator()(AccMut acc, const pg8::Unit& u, int wr, int wc, int fr, int fq) const {
        const int n = u.pm >> 5, pm = u.pm & 31, pn = u.pn & 7;
        const int row0 = pm * 256 + wr * 64 + fr, col0 = pn * 256 + wc * 32 + 8 * fq;
        const bf16_t* mg = (const bf16_t*)(ws + WS_MG) + n * 2048; bf16_t* mrg = (bf16_t*)(ws + WS_MRG);
#pragma unroll
        for (int ai = 0; ai < 2; ++ai)
#pragma unroll
            for (int m = 0; m < 4; ++m) { const int row = row0 + ai * 128 + m * 16;
#pragma unroll
                for (int bj = 0; bj < 2; ++bj) { const int col = col0 + bj * 128;
                    f32x4 g0, g1; unpack_gate(*(const u32x4*)(mg + (size_t)row * 6144 + col), g0, g1);
#pragma unroll
                    for (int j = 0; j < 4; ++j) { g0[j] = fmaxf(g0[j], 1e-20f); g1[j] = fmaxf(g1[j], 1e-20f); }
                    if (n < 2) { f32x4 h0, h1; unpack_gate(*(const u32x4*)(mg + (size_t)row * 6144 + 2048 + col), h0, h1);
#pragma unroll
                        for (int j = 0; j < 4; ++j) { g0[j] *= __builtin_amdgcn_rcpf(fmaxf(h0[j], 1e-20f)); g1[j] *= __builtin_amdgcn_rcpf(fmaxf(h1[j], 1e-20f)); }
                        acc[ai][bj][m][0] *= g0; acc[ai][bj][m][1] *= g1;
                    } else {
                        const f32x4 v0 = acc[ai][bj][m][0] * g0, v1 = acc[ai][bj][m][1] * g1;
                        u32x4 w; w.x = pk2(v0[0], v0[1]); w.y = pk2(v0[2], v0[3]); w.z = pk2(v1[0], v1[1]); w.w = pk2(v1[2], v1[3]); *(u32x4*)(mrg + (size_t)row * 2048 + col) = w; } } }
    }
};

struct Epi4 {
    static constexpr bool PERM = true;
    __device__ __forceinline__ bool keep_acc(const pg8::Unit&) const { return false; }
    bf16_t* O;
    __device__ __forceinline__ void operator()(AccRef acc, const pg8::Unit& u, int wr, int wc, int fr, int fq) const {
        store_bf16_tile<0>(acc, O + u.pn * 256, 2048, u.pm * 256 + wr * 64 + fr, wc * 32 + 8 * fq);
    }
};

__device__ __forceinline__ int map_bt1(int n, float& sc) {
    n = (((13 * (n >> 8)) & 63) << 8) | (n & 255);
    sc = 1.f;
    if (n < 768) return n;
    if (n < 1792) return 832 + (n - 768);
    if (n < 2816) { sc = LOG2E * 0.08838834764831845f; return 1856 + (n - 1792); }
    if (n < 3840) return 2880 + (n - 2816);
    if (n < 4864) return 3904 + (n - 3840);
    if (n < 5888) return 4936 + (n - 4864);
    if (n < 6912) { sc = LOG2E * 0.08838834764831845f; return 5960 + (n - 5888); }
    if (n < 7936) return 6984 + (n - 6912);
    if (n < 8960) return 8008 + (n - 7936);
    if (n < 9984) return 9032 + (n - 8960);
    if (n < 16128) return 10056 + (n - 9984);
    const int r = n - 16128;
    if (r < 64) return 768 + 32 * (r & 1) + (r >> 1);
    if (r < 72) return 4928 + (r - 64);
    return -1;
}
constexpr int CT_BT1 = 128 * 16, CT_BT2Q = 12 * 4, CT_BT2KV = 16 * 2, CT_BT3 = 3 * 16 * 8, CT_BT4 = 16 * 16, CT_LAYER = CT_BT1 + CT_BT2Q + CT_BT2KV + CT_BT3 + CT_BT4;
constexpr int NJ_MOD = 192, NJ_CS = 64, NJ_CONV = NLAYER * CT_LAYER, NJ_TOTAL = NJ_MOD + NJ_CS + NJ_CONV;

__device__ __forceinline__ void conv_tile(const Params& P, int job, LAS unsigned char* lds) {
    const int tid = my_tid();
    const int l = job / CT_LAYER; int r = job % CT_LAYER;
    unsigned char* wl = P.ws + WS_W + (size_t)l * SZ_WL;
    int kind, nt, kt; const float* src; int ld; bf16_t* dst; int Kd; const float* gain = nullptr; float gsc = 1.f;
    if (r < CT_BT1) { kind = 0; nt = r >> 4; kt = r & 15; src = P.w_in + (size_t)l * DM * DIN; ld = DIN; dst = (bf16_t*)wl; Kd = 2048; }
    else if ((r -= CT_BT1) < CT_BT2Q) { kind = 1; nt = r >> 2; kt = r & 3; src = P.w_uq + (size_t)l * 512 * 1536; ld = 1536; dst = (bf16_t*)(wl + OFF_BT2Q); Kd = 512; gain = P.qng + l * 512; gsc = LOG2E * 0.07216878364870323f; }
    else if ((r -= CT_BT2Q) < CT_BT2KV) { kind = 2; nt = r >> 1; kt = r & 1; src = P.w_ukv + (size_t)l * 256 * 2048; ld = 2048; dst = (bf16_t*)(wl + OFF_BT2KV); Kd = 256; gain = P.kvng + l * 256; }
    else if ((r -= CT_BT2KV) < CT_BT3) { kind = 3; const int br = r >> 7; r &= 127; nt = r >> 3; kt = r & 7; src = P.w_branch + ((size_t)l * 3 + br) * 1024 * 2048; ld = 2048; dst = (bf16_t*)(wl + OFF_BT3) + (size_t)br * 2048 * 1024; Kd = 1024; }
    else { r -= CT_BT3; kind = 4; nt = r >> 4; kt = r & 15; src = P.w_out + (size_t)l * 2048 * 2048; ld = 2048; dst = (bf16_t*)(wl + OFF_BT4); Kd = 2048; }
    const int nl = tid & 127, kb = tid >> 7, n = nt * 128 + nl;
    int sc_col; float sc = 1.f;
    if (kind == 0) sc_col = map_bt1(n, sc);
    else if (kind == 1) { if (n < 1024) sc_col = (n >> 7) * 192 + (n & 127); else { const int q = n - 1024, h = q >> 6, rr = q & 63; sc_col = h * 192 + 128 + 32 * (rr & 1) + (rr >> 1); } sc = gsc; }
    else if (kind == 2) { if (n < 1024) sc_col = (n >> 7) * 256 + (n & 127); else { const int q = n - 1024; sc_col = (q >> 7) * 256 + 128 + (q & 127); } }
    else sc_col = n;
    LAS bf16_t* tl = (LAS bf16_t*)lds;
    const float* sp = src + (size_t)(kt * 128 + kb) * ld + (sc_col < 0 ? 0 : sc_col);
    float v[32];
#pragma unroll
    for (int i = 0; i < 32; ++i) v[i] = (sc_col >= 0) ? __builtin_nontemporal_load(sp + (size_t)(4 * i) * ld) : 0.f;
#pragma unroll
    for (int i = 0; i < 32; ++i) { float g = sc; if (gain) g *= gain[kt * 128 + kb + 4 * i]; tl[nl * 130 + kb + 4 * i] = f2bf(v[i] * g); }
    __syncthreads();
    const int nr = tid >> 2, kc = tid & 3;
    const LAS unsigned* rp = (const LAS unsigned*)(lds + (nr * 130 + kc * 32) * 2);
    bf16_t* dp = dst + (size_t)(nt * 128 + nr) * Kd + kt * 128 + kc * 32;
#pragma unroll
    for (int q = 0; q < 4; ++q) { u32x4 w; w.x = rp[4 * q]; w.y = rp[4 * q + 1]; w.z = rp[4 * q + 2]; w.w = rp[4 * q + 3]; *(u32x4*)(dp + 8 * q) = w; }
}

__device__ __forceinline__ void mod_job(const Params& P, int job, LAS unsigned char* lds) {
    const int tid = my_tid(), l = job / 48, ct = job % 48;
    LAS float* cl = (LAS float*)lds;
    LAS float* part = (LAS float*)(lds + 32768);
    for (int i = tid; i < 4 * 2048; i += 512) cl[i] = P.c[i];
    __syncthreads();
    const int col = ct * 128 + (tid & 127), kg = tid >> 7;
    const float* wp = P.w_ada + (size_t)l * 2048 * 6144 + (size_t)(kg * 512) * 6144 + col;
    float a0 = 0.f, a1 = 0.f, a2 = 0.f, a3 = 0.f;
    for (int k = 0; k < 512; k += 8) {
        float w[8];
#pragma unroll
        for (int j = 0; j < 8; ++j) w[j] = __builtin_nontemporal_load(wp + (size_t)(k + j) * 6144);
#pragma unroll
        for (int j = 0; j < 8; ++j) { const int kk = kg * 512 + k + j; a0 += cl[kk] * w[j]; a1 += cl[2048 + kk] * w[j]; a2 += cl[4096 + kk] * w[j]; a3 += cl[6144 + kk] * w[j]; }
    }
    part[(kg * 4 + 0) * 128 + (tid & 127)] = a0; part[(kg * 4 + 1) * 128 + (tid & 127)] = a1; part[(kg * 4 + 2) * 128 + (tid & 127)] = a2; part[(kg * 4 + 3) * 128 + (tid & 127)] = a3;
    __syncthreads();
    { const int b = tid >> 7, c = tid & 127; const float s = part[(0 * 4 + b) * 128 + c] + part[(1 * 4 + b) * 128 + c] + part[(2 * 4 + b) * 128 + c] + part[(3 * 4 + b) * 128 + c];
      ((float*)(P.ws + WS_MOD))[((size_t)l * 4 + b) * 6144 + ct * 128 + c] = s + P.b_ada[(size_t)l * 6144 + ct * 128 + c]; }
}

__device__ __forceinline__ void cs_job(const Params& P, int job) {
    f32x2* cs = (f32x2*)(P.ws + WS_CS);
    const int tid = my_tid();
#pragma unroll
    for (int i = 0; i < 8; ++i) { const int idx = job * 4096 + i * 512 + tid; const int tok = idx >> 5, j = idx & 31;
        double pw = 1.0, bs = 0.749894209332456; { if (j & 1) pw *= bs; bs *= bs; if (j & 2) pw *= bs; bs *= bs; if (j & 4) pw *= bs; bs *= bs; if (j & 8) pw *= bs; bs *= bs; if (j & 16) pw *= bs; }
        const float ang = (float)P.pos[tok] * (float)pw;
        double rev = (double)ang * 0.15915494309189535; rev -= __builtin_rint(rev);
        const float rf = (float)rev;
        cs[idx] = (f32x2){__builtin_amdgcn_cosf(rf), __builtin_amdgcn_sinf(rf)}; }
}

__device__ __forceinline__ void phase_prologue(const Params& P, LAS unsigned char* lds, int ci) {
    const int G = my_G(), c = my_bx();
    if (G == 256) {
        static_assert(NJ_MOD == 192 && NJ_CS == 64 && NJ_CONV == 41 * 256 + 9 * 64, "static prologue deal");
        if (c < NJ_MOD) mod_job(P, c, lds); else cs_job(P, c - NJ_MOD);
#pragma unroll 1
        for (int r = 0; r < 41; ++r) { __syncthreads(); conv_tile(P, r * 256 + c, lds); }
        if (c >= NJ_MOD) {
#pragma unroll 1
            for (int j = 0; j < 9; ++j) { __syncthreads(); conv_tile(P, 41 * 256 + (c - NJ_MOD) + 64 * j, lds); }
        }
        __syncthreads();
        return;
    }
    unsigned* ctr = (unsigned*)(P.ws + WS_CTR) + ci * 16;
    LAS int* slot = (LAS int*)(lds + 131072);
    const int tid0 = my_tid();
    for (;;) {
        __syncthreads();
        if (tid0 == 0) *slot = (int)atomicAdd(ctr, 1u);
        __syncthreads();
        const int job = *slot;
        if (job >= NJ_TOTAL) break;
        if (job < NJ_MOD) mod_job(P, job, lds);
        else if (job < NJ_MOD + NJ_CS) cs_job(P, job - NJ_MOD);
        else conv_tile(P, job - NJ_MOD - NJ_CS, lds);
    }
}

__device__ __forceinline__ void row_stats(const f32x4 (&v)[8], float& mean, float& rstd) {
    float s = 0.f;
#pragma unroll
    for (int i = 0; i < 8; ++i) s += (v[i][0] + v[i][1]) + (v[i][2] + v[i][3]);
    mean = wave_sum(s) * (1.f / 2048.f);
    float q = 0.f;
#pragma unroll
    for (int i = 0; i < 8; ++i) { const f32x4 d = v[i] - mean; q += (d[0] * d[0] + d[1] * d[1]) + (d[2] * d[2] + d[3] * d[3]); }
    rstd = rsqrtf(wave_sum(q) * (1.f / 2048.f) + 1e-5f);
}
__device__ __forceinline__ void phase_ln(const Params& P, int l) {
    const int tid = my_tid(), bx = my_bx(), G = my_G();
    const int wid = tid >> 6, lane = tid & 63;
    float* X = (float*)(P.ws + WS_X); bf16_t* U = (bf16_t*)(P.ws + WS_U);
    const float* xsrc = (l <= 1) ? P.x : X;
    const bf16_t* outb = (const bf16_t*)(P.ws + WS_MRG2);
    const float* g = P.ln_g + (size_t)(l > 0 ? l - 1 : 0) * 2048; const float* bb = P.ln_b + (size_t)(l > 0 ? l - 1 : 0) * 2048;
    const float* mod = (const float*)(P.ws + WS_MOD) + (size_t)(l < 4 ? l : 0) * 4 * 6144;
    const float* gate = (const float*)(P.ws + WS_MOD) + (size_t)(l > 0 ? l - 1 : 0) * 4 * 6144 + 4096;
    for (int row = bx * 8 + wid; row < T; row += G * 8) {
        f32x4 v[8];
#pragma unroll
        for (int i = 0; i < 8; ++i) v[i] = *(const f32x4*)(xsrc + (size_t)row * 2048 + (i * 64 + lane) * 4);
        if (l >= 1) {
            const float* gp = gate + (size_t)(row >> 11) * 6144;
#pragma unroll
            for (int i = 0; i < 8; ++i) { const int col = (i * 64 + lane) * 4; const u32x2 ow = *(const u32x2*)(outb + (size_t)row * 2048 + col); const f32x4 gv = *(const f32x4*)(gp + col);
                f32x4 o; o[0] = __uint_as_float(ow.x << 16); o[1] = __uint_as_float(ow.x & 0xffff0000u); o[2] = __uint_as_float(ow.y << 16); o[3] = __uint_as_float(ow.y & 0xffff0000u);
                v[i] = v[i] * ALPHA + gv * o; }
        }
        float mean, rstd; row_stats(v, mean, rstd);
        if (l >= 1) {
            float* dst = (l == 4) ? P.out : X;
#pragma unroll
            for (int i = 0; i < 8; ++i) { const int col = (i * 64 + lane) * 4; const f32x4 gv = *(const f32x4*)(g + col), bv = *(const f32x4*)(bb + col);
                v[i] = (v[i] - mean) * rstd * gv + bv; *(f32x4*)(dst + (size_t)row * 2048 + col) = v[i]; }
            if (l == 4) continue;
            row_stats(v, mean, rstd);
        }
        const float* mp = mod + (size_t)(row >> 11) * 6144;
#pragma unroll
        for (int i = 0; i < 8; ++i) { const int col = (i * 64 + lane) * 4; const f32x4 sh = *(const f32x4*)(mp + col), sc = *(const f32x4*)(mp + 2048 + col);
            const f32x4 uu = (v[i] - mean) * rstd * (sc + 1.f) + sh; u32x2 w; w.x = pk2(uu[0], uu[1]); w.y = pk2(uu[2], uu[3]);
            *(u32x2*)(U + (size_t)row * 2048 + col) = w; }
    }
}

__device__ __forceinline__ void phase_small(const Params& P, int l) {
    const float* misc = (const float*)(P.ws + WS_MISC); const f32x2* cs = (const f32x2*)(P.ws + WS_CS); bf16_t* kr = (bf16_t*)(P.ws + WS_KR);
    const int tid = my_tid(), bx = my_bx(), G = my_G();
    const int rb0 = (G == 256) ? 192 : 0, rnb = G - rb0;
    for (int idx = (bx - rb0) * 512 + tid; idx < T * 32 && bx >= rb0; idx += rnb * 512) { const int tok = idx >> 5, j = idx & 31;
        const f32x2 x = *(const f32x2*)(misc + (size_t)tok * 128 + 2 * j); const f32x2 c = cs[idx];
        *(unsigned*)(kr + (size_t)tok * 64 + 2 * j) = pk2(x[0] * c[0] - x[1] * c[1], x[1] * c[0] + x[0] * c[1]); }
    const int wid = tid >> 6, lane = tid & 63;
    const int fb0 = (G >= 200) ? 192 : 0;
    for (int sid = (bx - fb0) * 8 + wid; sid < 32 && bx >= fb0; sid += G * 8) { const int b = sid >> 3, h = sid & 7; const float bias = P.fox_bias[l * 8 + h];
        float loc[32]; float run = 0.f;
#pragma unroll
        for (int i = 0; i < 32; ++i) { const int s = lane * 32 + i; const float xx = misc[(size_t)(b * 2048 + s) * 128 + 64 + h] + bias;
            const float ls = -(fmaxf(-xx, 0.f) + log1pf(expf(-fabsf(xx)))); run += ls; loc[i] = run; }
        float incl = run;
#pragma unroll
        for (int o = 1; o < 64; o <<= 1) { const float t = __shfl_up(incl, o); if (lane >= o) incl += t; }
        const float excl = incl - run; float* fc = (float*)(P.ws + WS_FC) + (size_t)sid * 2048 + lane * 32;
#pragma unroll
        for (int i = 0; i < 32; ++i) fc[i] = (loc[i] + excl) * LOG2E; }
}

#define MFMA32(a, b, c) __builtin_amdgcn_mfma_f32_32x32x16_bf16((a), (b), (c), 0, 0, 0)
__device__ __forceinline__ bf16x8 pack8(const f32x16& x, int s) {
    u32x4 p;
    if (s == 0) { p.x = pk2(x[0], x[1]); p.y = pk2(x[2], x[3]); p.z = pk2(x[4], x[5]); p.w = pk2(x[6], x[7]); }
    else { p.x = pk2(x[8], x[9]); p.y = pk2(x[10], x[11]); p.z = pk2(x[12], x[13]); p.w = pk2(x[14], x[15]); }
    return __builtin_bit_cast(bf16x8, p);
}
__device__ __forceinline__ float exp2_negabs(float x) { float r; asm("v_exp_f32 %0, -|%1|\n\ts_nop 1" : "=v"(r) : "v"(x)); return r; }
__device__ __forceinline__ void sb_sub(f32x16& s, float& carry, const int hh) {
    float w[16];
#pragma unroll
    for (int i = 0; i < 16; ++i) { const float z = s[i]; const float t = log2_(1.f + exp2_negabs(z));
        w[i] = -(__builtin_fmaxf(z, 0.f) + t); }
    const float GA = ((w[0] + w[1]) + (w[2] + w[3])) + ((w[4] + w[5]) + (w[6] + w[7])), GB = ((w[8] + w[9]) + (w[10] + w[11])) + ((w[12] + w[13]) + (w[14] + w[15]));
    const float GAp = swap_partner(GA, hh), GBp = swap_partner(GB, hh);
    float a = carry + (hh == 0 ? GBp : 0.f);
#pragma unroll
    for (int i = 15; i >= 8; --i) { const float wi = w[i]; s[i] = exp2_((s[i] + wi) + a); a += wi; }
    a = carry + GB + GBp + (hh == 0 ? GAp : 0.f);
#pragma unroll
    for (int i = 7; i >= 0; --i) { const float wi = w[i]; s[i] = exp2_((s[i] + wi) + a); a += wi; }
    carry += (GA + GB) + (GAp + GBp);
}

template <int N> __device__ __forceinline__ void at_waitv() {
    if constexpr (N == 0) asm volatile("s_waitcnt vmcnt(0)" ::: "memory");
    else if constexpr (N == 2) asm volatile("s_waitcnt vmcnt(2)" ::: "memory");
    else if constexpr (N == 3) asm volatile("s_waitcnt vmcnt(3)" ::: "memory");
    else if constexpr (N == 4) asm volatile("s_waitcnt vmcnt(4)" ::: "memory");
    else if constexpr (N == 5) asm volatile("s_waitcnt vmcnt(5)" ::: "memory");
    else static_assert(N == 0, "at_waitv: add the count");
}
#define AT_BAR() do { asm volatile("" ::: "memory"); __builtin_amdgcn_s_barrier(); asm volatile("" ::: "memory"); } while (0)
template <int TYPE  >
__device__ __forceinline__ void attn_item(const Params& P, const int b, const int h, const int qt, LAS unsigned char* lds) {
    constexpr int DQK = TYPE == 0 ? 192 : 128, KS = DQK / 16, KROWB = DQK * 2, KREG = 64 * KROWB, VREG = 16384, FREG = TYPE == 1 ? 2048 : 0, SLOT = KREG + VREG + FREG;
    constexpr int NKI = KREG / 8192, NI = NKI + 2 + (TYPE == 1 ? 1 : 0), FLAGS = 126976;
    static_assert(3 * SLOT <= FLAGS && SLOT % 256 == 0, "ring");
    const int tid = my_tid(), wid = __builtin_amdgcn_readfirstlane(tid >> 6), lane = tid & 63, l32 = lane & 31, hh = lane >> 5;
    unsigned char* ws = P.ws;
    const int bh = b * 8 + h;
    const int tq = qt * 256 + wid * 32 + l32;
    const size_t tokq = (size_t)b * 2048 + tq;
    const int NT = 4 * qt + 4, wlast = 4 * qt + (wid >> 1);
    const char* kptr[NKI]; unsigned kstr[NKI]; const char* vptr[2];
    const char* Kbase = (const char*)(ws + (TYPE == 0 ? WS_KAN : TYPE == 1 ? WS_KB : WS_KC));
#pragma unroll
    for (int i = 0; i < NKI; ++i) { const int p = (wid * NKI + i) * 64 + lane;
        if (TYPE == 0) { const int rho = p / 24, cp = p - rho * 24, c = (cp & ~7) | ((cp & 7) ^ ((rho >> 1) & 7));
            if (c < 16) { kptr[i] = Kbase + ((size_t)(b * 2048 + rho) * 1024 + h * 128) * 2 + c * 16; kstr[i] = 131072u; }
            else { kptr[i] = (const char*)(ws + WS_KR) + (size_t)(b * 2048 + rho) * 128 + (c - 16) * 16; kstr[i] = 8192u; }
        } else { const int rho = p >> 4, c = (p & 15) ^ (rho & 15); kptr[i] = Kbase + ((size_t)(b * 2048 + rho) * 1024 + h * 128) * 2 + c * 16; kstr[i] = 131072u; } }
    const char* Vbase = (const char*)(ws + (TYPE == 0 ? WS_VAT : TYPE == 1 ? WS_VBT : WS_VCT));
#pragma unroll
    for (int i = 0; i < 2; ++i) { const int p = (wid * 2 + i) * 64 + lane, r = p >> 3, c = (p & 7) ^ ((r >> 1) & 7); vptr[i] = Vbase + ((size_t)(bh * 128 + r) * 2048) * 2 + c * 16; }
    const char* fptr = (const char*)(ws + WS_FC) + ((size_t)bh * 2048 + lane) * 4;
#define AT_ISSUE(kt, so) do { \
        _Pragma("unroll") for (int i_ = 0; i_ < NKI; ++i_) __builtin_amdgcn_global_load_lds((const unsigned*)(kptr[i_] + (size_t)(kt) * kstr[i_]), (LAS unsigned*)(lds + (so) + (wid * NKI + i_) * 1024), 16, 0, 0); \
        _Pragma("unroll") for (int i_ = 0; i_ < 2; ++i_) __builtin_amdgcn_global_load_lds((const unsigned*)(vptr[i_] + (size_t)(kt) * 128), (LAS unsigned*)(lds + (so) + KREG + (wid * 2 + i_) * 1024), 16, 0, 0); \
        if (TYPE == 1) __builtin_amdgcn_global_load_lds((const unsigned*)(fptr + (size_t)(kt) * 256), (LAS unsigned*)(lds + (so) + KREG + VREG + wid * 256), 4, 0, 0); } while (0)
#define AT_TILE(it_) (TYPE == 2 ? NT - 1 - (it_) : (it_))
    float m_run = -1e30f, l_run = 0.f, carry = 0.f;
    f32x16 o0, o1, o2, o3;
#pragma unroll
    for (int i = 0; i < 16; ++i) { o0[i] = 0.f; o1[i] = 0.f; o2[i] = 0.f; o3[i] = 0.f; }
    const int pl = (l32 & ~12) | ((l32 & 4) << 1) | ((l32 & 8) >> 1);
    const unsigned a0k = (unsigned)(pl * KROWB + ((((TYPE == 0) ? ((pl >> 1) & 7) : (pl & 15)) ^ hh) << 4));
    const unsigned a0v = (unsigned)(KREG + l32 * 128 + ((((l32 >> 1) & 7) ^ hh) << 4));
    const bool ahead = false; bool have_s = false; bool wv_done = false;
    f32x16 s0, s1;
#define AT_KADDR(ks) ((TYPE == 0) ? ((kb_ ^ (unsigned)(32 * ((ks) & 3))) + (unsigned)(((ks) >> 2) * 128)) : (kb_ ^ (unsigned)(32 * (ks))))
#define AT_RK(c) do { _Pragma("unroll") for (int ks = CH * (c); ks < CH * (c) + CH; ++ks) { const unsigned ka = AT_KADDR(ks); kfa[ks] = *(const LAS bf16x8*)(lds + ka); kfb[ks] = *(const LAS bf16x8*)(lds + ka + 32 * KROWB); } } while (0)
#define AT_MK(c) do { __builtin_amdgcn_s_setprio(1); _Pragma("unroll") for (int ks = CH * (c); ks < CH * (c) + CH; ++ks) { s0 = MFMA32(kfa[ks], qf[ks], s0); s1 = MFMA32(kfb[ks], qf[ks], s1); } __builtin_amdgcn_s_setprio(0); } while (0)
    constexpr int CH = (KS == 12) ? 3 : 4, NC = KS / CH;
#define AT_QK(so_) do { \
        _Pragma("unroll") for (int i_ = 0; i_ < 16; ++i_) { s0[i_] = 0.f; s1[i_] = 0.f; } \
        const unsigned kb_ = a0k + (so_); bf16x8 kfa[KS], kfb[KS]; \
        AT_RK(0); \
        _Pragma("unroll") for (int c_ = 0; c_ < NC; ++c_) { if (c_ + 1 < NC) { AT_RK(c_ + 1); } __builtin_amdgcn_sched_barrier(0); AT_MK(c_); __builtin_amdgcn_sched_barrier(0); } \
          \
        asm volatile("s_nop 7\n\ts_nop 7\n\ts_nop 3" : "+v"(s0), "+v"(s1)); } while (0)
    at_waitv<0>(); AT_BAR();
    AT_ISSUE(AT_TILE(0), 0); AT_ISSUE(AT_TILE(1), SLOT);
    bf16x8 qf[KS];
    if (TYPE == 0) {
        const bf16_t* qn = (const bf16_t*)(ws + WS_QAN) + tokq * 1024 + h * 128 + hh * 8; const bf16_t* qr = (const bf16_t*)(ws + WS_QAR) + tokq * 512 + h * 64 + hh * 8;
#pragma unroll
        for (int ks = 0; ks < 8; ++ks) qf[ks] = *(const bf16x8*)(qn + ks * 16);
#pragma unroll
        for (int ks = 8; ks < KS; ++ks) qf[ks] = *(const bf16x8*)(qr + (ks - 8) * 16);
    } else {
        const bf16_t* qp = (const bf16_t*)(ws + (TYPE == 1 ? WS_QB : WS_QC)) + tokq * 1024 + h * 128 + hh * 8;
#pragma unroll
        for (int ks = 0; ks < KS; ++ks) qf[ks] = *(const bf16x8*)(qp + ks * 16);
    }
#pragma unroll
    for (int ks = 0; ks < KS; ++ks) asm volatile("" : "+v"(qf[ks]));
    unsigned so = 0, so2 = 2 * SLOT;
    for (int it = 0; it < NT; ++it) {
        const int kt = AT_TILE(it);
        if (it + 1 < NT) at_waitv<NI>(); else at_waitv<0>();
        AT_BAR();
        if (TYPE == 2 && it > 0) { const LAS int* fl = (const LAS int*)(lds + FLAGS + ((it - 1) & 1) * 32);
            if (fl[0] & fl[1] & fl[2] & fl[3] & fl[4] & fl[5] & fl[6] & fl[7]) break; }
        if (it + 2 < NT) AT_ISSUE(AT_TILE(it + 2), so2);
        if (kt <= wlast && !(TYPE == 2 && wv_done)) {
            if (!have_s) { AT_QK(so); }
            const unsigned vb = a0v + so;
            bf16x8 vf0[4], vf1[4], vf2[4], vf3[4];
#define AT_RV(vf, mb) do { vf[0] = *(const LAS bf16x8*)(lds + vb + (mb) * 4096); vf[1] = *(const LAS bf16x8*)(lds + (vb ^ 32u) + (mb) * 4096); \
                vf[2] = *(const LAS bf16x8*)(lds + (vb ^ 64u) + (mb) * 4096); vf[3] = *(const LAS bf16x8*)(lds + (vb ^ 96u) + (mb) * 4096); } while (0)
            AT_RV(vf0, 0);
            __builtin_amdgcn_sched_barrier(0);
            const bool diag = (kt == wlast);
            const int key0 = kt * 64 + 8 * hh;
            if (TYPE == 2) {
                if (diag) {
#pragma unroll
                    for (int i = 0; i < 16; ++i) { const int key = key0 + 16 * (i >> 3) + (i & 7); if (key >= tq) s0[i] = -1e30f; if (key + 32 >= tq) s1[i] = -1e30f; } }
                sb_sub(s1, carry, hh); sb_sub(s0, carry, hh);
            } else {
                if (TYPE == 1) { const LAS float* fb = (const LAS float*)(lds + so + KREG + VREG + wid * 256) + 8 * hh;
#pragma unroll
                    for (int j = 0; j < 8; ++j) {
                        const f32x2 b0 = *(const LAS f32x2*)(fb + 16 * (j >> 2) + 2 * (j & 3)), b1 = *(const LAS f32x2*)(fb + 32 + 16 * (j >> 2) + 2 * (j & 3));
                        const f32x2 x0 = pk_sub((f32x2){s0[2 * j], s0[2 * j + 1]}, b0), x1 = pk_sub((f32x2){s1[2 * j], s1[2 * j + 1]}, b1);
                        s0[2 * j] = x0[0]; s0[2 * j + 1] = x0[1]; s1[2 * j] = x1[0]; s1[2 * j + 1] = x1[1]; }
                    if (diag) {
#pragma unroll
                        for (int i = 0; i < 16; ++i) { const int key = key0 + 16 * (i >> 3) + (i & 7); if (key > tq) s0[i] = -1e30f; if (key + 32 > tq) s1[i] = -1e30f; } } }
                float mx = m_run;
#pragma unroll
                for (int i = 0; i < 16; ++i) mx = max3_(mx, s0[i], s1[i]);
                asm volatile("s_nop 1" : "+v"(mx));
                const float mnew = swap_max(mx);
                const f32x2 mm = {mnew, mnew}; f32x2 rs2 = {0.f, 0.f};
#pragma unroll
                for (int j = 0; j < 8; ++j) { const f32x2 x0 = pk_sub((f32x2){s0[2 * j], s0[2 * j + 1]}, mm), x1 = pk_sub((f32x2){s1[2 * j], s1[2 * j + 1]}, mm);
                    s0[2 * j] = exp2_(x0[0]); s0[2 * j + 1] = exp2_(x0[1]); s1[2 * j] = exp2_(x1[0]); s1[2 * j + 1] = exp2_(x1[1]);
                    rs2 += (f32x2){s0[2 * j], s0[2 * j + 1]} + (f32x2){s1[2 * j], s1[2 * j + 1]}; }
                const float rs = rs2[0] + rs2[1];
                if (__any(mnew > m_run)) {
                    const float alpha = exp2_(m_run - mnew);
                    l_run *= alpha; o0 *= alpha; o1 *= alpha; o2 *= alpha; o3 *= alpha;
                }
                l_run += rs; m_run = mnew;
            }
            const bf16x8 p00 = pack8(s0, 0), p01 = pack8(s0, 1), p10 = pack8(s1, 0), p11 = pack8(s1, 1);
#define AT_PV(o, vf) do { __builtin_amdgcn_s_setprio(1); o = MFMA32(vf[0], p00, o); o = MFMA32(vf[1], p01, o); o = MFMA32(vf[2], p10, o); o = MFMA32(vf[3], p11, o); __builtin_amdgcn_s_setprio(0); } while (0)
            __builtin_amdgcn_sched_barrier(0);
            AT_RV(vf1, 1); AT_PV(o0, vf0); __builtin_amdgcn_sched_barrier(0);
            AT_RV(vf2, 2); AT_PV(o1, vf1); __builtin_amdgcn_sched_barrier(0);
            AT_RV(vf3, 3); AT_PV(o2, vf2); __builtin_amdgcn_sched_barrier(0);
            AT_PV(o3, vf3); __builtin_amdgcn_sched_barrier(0);
#undef AT_PV
#undef AT_RV
        }
        if (TYPE == 2) { wv_done = wv_done || ((kt <= wlast) && __all(carry < -140.f)); if (lane == 0) *(LAS int*)(lds + FLAGS + (it & 1) * 32 + wid * 4) = wv_done ? 1 : 0; }
        so = (so == 2 * SLOT) ? 0u : so + SLOT; so2 = (so2 == 2 * SLOT) ? 0u : so2 + SLOT;
        have_s = false;
        if (ahead && it + 1 < NT && AT_TILE(it + 1) <= wlast) { AT_QK(so); have_s = true; }
    }
#undef AT_ISSUE
#undef AT_TILE
#undef AT_QK
#undef AT_RK
#undef AT_MK
#undef AT_KADDR
    float inv = 1.f;
    if (TYPE != 2) inv = 1.f / swap_sum(l_run);
    at_waitv<0>(); AT_BAR();
    {
        const unsigned ob = (unsigned)(wid * 8704 + l32 * 272 + 8 * hh);
#define AT_OUT(o, mb) do { _Pragma("unroll") for (int g = 0; g < 4; ++g) { u32x2 w; w.x = pk2(o[4 * g] * inv, o[4 * g + 1] * inv); w.y = pk2(o[4 * g + 2] * inv, o[4 * g + 3] * inv); \
            *(LAS u32x2*)(lds + ob + (mb) * 64 + g * 16) = w; } } while (0)
        AT_OUT(o0, 0); AT_OUT(o1, 1); AT_OUT(o2, 2); AT_OUT(o3, 3);
#undef AT_OUT
        const size_t tok0 = (size_t)b * 2048 + qt * 256 + wid * 32;
        const bf16_t* sg = (const bf16_t*)(ws + WS_SG) + (size_t)TYPE * T * 1024 + tok0 * 1024 + h * 128;
        bf16_t* ys = (bf16_t*)(ws + WS_YS) + (size_t)TYPE * T * 1024 + tok0 * 1024 + h * 128;
        u32x4 gv[8];
#pragma unroll
        for (int i = 0; i < 8; ++i) { const int c = lane + 64 * i, r = c >> 4, cc = c & 15; gv[i] = *(const u32x4*)(sg + (size_t)r * 1024 + cc * 8); }
#pragma unroll
        for (int i = 0; i < 8; ++i) { const int c = lane + 64 * i, r = c >> 4, cc = c & 15;
            const u32x4 ov = *(const LAS u32x4*)(lds + wid * 8704 + r * 272 + cc * 16); u32x4 w;
            w.x = pk2(__uint_as_float(ov.x << 16) * __uint_as_float(gv[i].x << 16), __uint_as_float(ov.x & 0xffff0000u) * __uint_as_float(gv[i].x & 0xffff0000u));
            w.y = pk2(__uint_as_float(ov.y << 16) * __uint_as_float(gv[i].y << 16), __uint_as_float(ov.y & 0xffff0000u) * __uint_as_float(gv[i].y & 0xffff0000u));
            w.z = pk2(__uint_as_float(ov.z << 16) * __uint_as_float(gv[i].z << 16), __uint_as_float(ov.z & 0xffff0000u) * __uint_as_float(gv[i].z & 0xffff0000u));
            w.w = pk2(__uint_as_float(ov.w << 16) * __uint_as_float(gv[i].w << 16), __uint_as_float(ov.w & 0xffff0000u) * __uint_as_float(gv[i].w & 0xffff0000u));
            *(u32x4*)(ys + (size_t)r * 1024 + cc * 8) = w; }
    }
}

__device__ __forceinline__ void attn_run(const Params& P, int type, int bh, int qt, LAS unsigned char* lds) {
    const int b = bh >> 3, h = bh & 7;
#ifndef ATT_MASK
#define ATT_MASK 7
#endif
    if ((ATT_MASK & 1) && type == 0) attn_item<0>(P, b, h, qt, lds); else if ((ATT_MASK & 2) && type == 1) attn_item<1>(P, b, h, qt, lds); else if ((ATT_MASK & 4) && type == 2) attn_item<2>(P, b, h, qt, lds);
}
__device__ __forceinline__ void phase_attn(const Params& P, LAS unsigned char* lds) {
    const int G = my_G(), c = my_bx();
    if (G == 256) {
        const int x = c & 7, j = c >> 3, bh = 4 * x + (j >> 3), k = j & 7;
        const int kf = (k == 7) ? 1 : (k == 6) ? 0 : 7 - k;
#pragma unroll 1
        for (int r = 0; r < 3; ++r) attn_run(P, r, bh, r == 0 ? k : r == 1 ? kf : 7 - k, lds);
    } else {
#pragma unroll 1
        for (int idx = c; idx < 768; idx += G) { const int qt = 7 - idx / 96, r = idx % 96; attn_run(P, r >> 5, r & 31, qt, lds); }
    }
    asm volatile("s_waitcnt vmcnt(0)" ::: "memory"); __syncthreads();
}

#define XB_TMO      128
#define XB_XCNT(j)  (256  + 64 * (j))
#define XB_XSUB(j)  (1280 + 64 * (j))
#define XB_XGEN(j)  (2304 + 64 * (j))
#define XB_TOP      3328
#define XB_TOPGEN   3392
#define XCD_BAR_WORDS 3456
#define XB_SPIN_CAP (1u << 18)
__device__ __forceinline__ unsigned xb_ld(unsigned* p)              { return __hip_atomic_load(p, __ATOMIC_RELAXED, __HIP_MEMORY_SCOPE_AGENT); }
__device__ __forceinline__ unsigned xb_add(unsigned* p, unsigned v) { return __hip_atomic_fetch_add(p, v, __ATOMIC_RELAXED, __HIP_MEMORY_SCOPE_AGENT); }
__device__ __forceinline__ unsigned xb_xcc_id() { return (unsigned)__builtin_amdgcn_s_getreg((3 << 11) | 20) & 0xFu; }
#define XB_SPIN(cond, bar) do { unsigned _sp = 0; while (cond) { __builtin_amdgcn_s_sleep(1); \
    if ((++_sp & 255u) == 0u) { if (xb_ld(&(bar)[XB_TMO])) break; if (_sp > XB_SPIN_CAP) { atomicAdd(&(bar)[XB_TMO], 1u); break; } } } } while (0)
struct XcdBarrier { unsigned* bar; unsigned x; volatile LAS unsigned* st; };
__device__ __forceinline__ XcdBarrier xcd_barrier_post(unsigned* bar, volatile LAS unsigned* st) {
    XcdBarrier b; b.bar = bar; b.x = xb_xcc_id(); b.st = st;
    if (threadIdx.x == 0) (void)xb_add(&bar[XB_XCNT(b.x)], 1u);
    return b;
}
__device__ __forceinline__ void xcd_barrier_complete(unsigned* bar, unsigned x, unsigned& nloc, unsigned& nx) {
    const unsigned G = gridDim.x * gridDim.y * gridDim.z;
    unsigned sum, cnt, mine, sp = 0u;
    for (;;) {
        sum = 0u; cnt = 0u; mine = 0u;
#pragma unroll
        for (unsigned j = 0; j < 16; ++j) { const unsigned c = xb_ld(&bar[XB_XCNT(j)]); sum += c; cnt += (c > 0u) ? 1u : 0u; mine = (j == x) ? c : mine; }
        if (sum == G) break;
        __builtin_amdgcn_s_sleep(1);
        if ((++sp & 255u) == 0u) { if (xb_ld(&bar[XB_TMO])) break; if (sp > XB_SPIN_CAP) { atomicAdd(&bar[XB_TMO], 1u); break; } }
    }
    nloc = mine > 0u ? mine : 1u; nx = cnt > 0u ? cnt : 1u;
}
__device__ __forceinline__ void xcd_barrier(const XcdBarrier& b) {
    asm volatile("s_waitcnt vmcnt(0)" ::: "memory");
    __syncthreads();
    if (threadIdx.x == 0) {
        unsigned* bar = b.bar;
        __builtin_amdgcn_s_waitcnt(0);
        unsigned nloc = b.st[0], nx = b.st[1];
        if (nloc == 0u) { xcd_barrier_complete(bar, b.x, nloc, nx); b.st[0] = nloc; b.st[1] = nx; }
        const unsigned old = xb_add(&bar[XB_XSUB(b.x)], 1u);
        const unsigned gen = old / nloc;
        if (old + 1u == (gen + 1u) * nloc) {
            __builtin_amdgcn_fence(__ATOMIC_RELEASE, "agent");
            asm volatile("s_waitcnt vmcnt(0)" ::: "memory");
            const unsigned og = xb_add(&bar[XB_TOP], 1u);
            const unsigned tg = og / nx;
            if (og + 1u == (tg + 1u) * nx) xb_add(&bar[XB_TOPGEN], 1u);
            else XB_SPIN(xb_ld(&bar[XB_TOPGEN]) == tg, bar);
            __builtin_amdgcn_fence(__ATOMIC_ACQUIRE, "agent");
            xb_add(&bar[XB_XGEN(b.x)], 1u);
            asm volatile("s_waitcnt vmcnt(0)" ::: "memory");
        } else {
            XB_SPIN(xb_ld(&bar[XB_XGEN(b.x)]) == gen, bar);
            __builtin_amdgcn_fence(__ATOMIC_ACQUIRE, "agent");
            asm volatile("s_waitcnt vmcnt(0)" ::: "memory");
        }
    }
    __syncthreads();
}

constexpr int N_PHASES = 2 + 6 * NLAYER;
__global__ void __launch_bounds__(512, 2) mega(Params P0) {
    extern __shared__ __attribute__((aligned(16))) unsigned char smem[];
    LAS unsigned char* lds = (LAS unsigned char*)smem;
    cg::grid_group grid = cg::this_grid();
    const int lo = P0.ph_lo, hi = P0.ph_hi;
    volatile LAS unsigned* xst = (volatile LAS unsigned*)(lds + 131072 + 16);
    if (threadIdx.x == 0) { xst[0] = 0u; xst[1] = 0u; }
    __syncthreads();
    const XcdBarrier xbar = xcd_barrier_post((unsigned*)(P0.ws + WS_BAR), xst);
#ifndef PH_MASK
#define PH_MASK 0xff
#endif
#ifndef DUP_MASK
#define DUP_MASK 0
#endif
#ifndef EXTRA_SYNC
#define EXTRA_SYNC 0
#endif
#define NDUP(bit) ((DUP_MASK & (bit)) ? 2 : 1)
#define IN(k) (lo <= (k) && (k) < hi)
#define SEAM(k) do { if (IN(k) && IN((k) + 1)) { if ((k) == 0) grid.sync(); else xcd_barrier(xbar); if (EXTRA_SYNC) xcd_barrier(xbar); } } while (0)
#define FRESH() Params P = P0; { unsigned char* w_ = P0.ws; asm volatile("" : "+s"(w_)); P.ws = w_; } unsigned char* ws = P.ws; (void)ws; const int G = my_G(), bx = my_bx(); (void)G; (void)bx
    if ((PH_MASK & 1) && IN(0)) { for (int d = 0; d < NDUP(1); ++d) { FRESH(); phase_prologue(P, lds, d); if (d + 1 < NDUP(1)) grid.sync(); } SEAM(0); }
#pragma unroll 1
    for (int l = 0; l < NLAYER; ++l) {
        const int p0 = 1 + 6 * l;
        if ((PH_MASK & 2) && IN(p0)) { FRESH(); phase_ln(P, l); SEAM(p0); }
        if ((PH_MASK & 4) && IN(p0 + 1)) {
            FRESH(); unsigned char* wl = ws + WS_W + (size_t)l * SZ_WL;
            __syncthreads();
            pg8::Gemm g{(const bf16_t*)(ws + WS_U), (const bf16_t*)wl, T, N1, DM}; pg8::StaticOrder S; S.init(T, N1, G, bx);
            Epi1 E{ws};
            for (int d = 0; d < NDUP(4); ++d) { pg8::gemm_phase<Epi1, pg8::StaticOrder, true, true>(lds, g, S, E); if (d + 1 < NDUP(4)) grid.sync(); }
            SEAM(p0 + 1);
        }
        if ((PH_MASK & 8) && IN(p0 + 2)) {
            { FRESH(); phase_small(P, l); }
            __syncthreads();
            { FRESH(); unsigned char* wl = ws + WS_W + (size_t)l * SZ_WL;
              pg8::Gemm g{(const bf16_t*)(ws + WS_CQ), (const bf16_t*)(wl + OFF_BT2Q), T, 1536, 512}; pg8::StaticOrder S; S.init(T, 1536, G, bx);
              Epi2<0> E{ws}; pg8::gemm_phase<Epi2<0>, pg8::StaticOrder, false, true>(lds, g, S, E); }
            __syncthreads();
            { FRESH(); unsigned char* wl = ws + WS_W + (size_t)l * SZ_WL;
              pg8::Gemm g{(const bf16_t*)(ws + WS_CKV), (const bf16_t*)(wl + OFF_BT2KV), T, 2048, 256}; pg8::StaticOrder S; S.init(T, 2048, G, bx);
              Epi2<1> E{ws}; pg8::gemm_phase<Epi2<1>, pg8::StaticOrder, false, true>(lds, g, S, E); }
            SEAM(p0 + 2);
        }
        if ((PH_MASK & 16) && IN(p0 + 3)) { for (int d = 0; d < NDUP(16); ++d) { FRESH(); phase_attn(P, lds); if (d + 1 < NDUP(16)) grid.sync(); } SEAM(p0 + 3); }
        if ((PH_MASK & 32) && IN(p0 + 4)) {
            FRESH(); unsigned char* wl = ws + WS_W + (size_t)l * SZ_WL;
            __syncthreads();
            pg8::Gemm g{(const bf16_t*)(ws + WS_YS), (const bf16_t*)(wl + OFF_BT3), 3 * T, 3 * 2048, 1024}; pg8::BranchOrder S; S.so.init(T, 2048, G, bx);
            Epi3 E{ws};
            pg8::gemm_phase<Epi3, pg8::BranchOrder, true, true>(lds, g, S, E);
            SEAM(p0 + 4);
        }
        if ((PH_MASK & 64) && IN(p0 + 5)) {
            FRESH(); unsigned char* wl = ws + WS_W + (size_t)l * SZ_WL;
            __syncthreads();
            pg8::Gemm g{(const bf16_t*)(ws + WS_MRG), (const bf16_t*)(wl + OFF_BT4), T, 2048, 2048}; pg8::StaticOrder S; S.init(T, 2048, G, bx);
            Epi4 E{(bf16_t*)(ws + WS_MRG2)};
            pg8::gemm_phase<Epi4, pg8::StaticOrder, false, true>(lds, g, S, E);
            SEAM(p0 + 5);
        }
    }
    if ((PH_MASK & 2) && IN(N_PHASES - 1)) { FRESH(); phase_ln(P, 4); }
#undef IN
#undef SEAM
#undef FRESH
}

extern "C" void kernel_launch(void* const* d_in, const int* in_sizes, int n_in, void* d_out, int out_size, void* d_ws, size_t ws_size, hipStream_t stream) {
    static int grid = 0;
    if (grid == 0) {
        if (n_in != 15 || ws_size < WS_END) { fprintf(stderr, "kernel_launch: bad inputs (n_in %d, ws %zu < %zu)\n", n_in, ws_size, (size_t)WS_END); grid = -1; return; }
        int dev = 0, cus = 0, per_cu = 0;
        hipGetDevice(&dev); hipDeviceGetAttribute(&cus, hipDeviceAttributeMultiprocessorCount, dev);
        if (hipFuncSetAttribute((const void*)mega, hipFuncAttributeMaxDynamicSharedMemorySize, LDS_BYTES) != hipSuccess) { fprintf(stderr, "kernel_launch: hipFuncSetAttribute failed\n"); grid = -1; return; }
        if (hipOccupancyMaxActiveBlocksPerMultiprocessor(&per_cu, (const void*)mega, 512, LDS_BYTES) != hipSuccess || per_cu < 1) { fprintf(stderr, "kernel_launch: occupancy query says %d\n", per_cu); per_cu = 1; }
        (void)hipGetLastError();
        grid = cus * per_cu;
    }
    if (grid < 0) return;
    (void)hipMemsetAsync((char*)d_ws + WS_CTR, 0, WS_ZERO_BYTES, stream);
    Params p{};
    p.x = (const float*)d_in[0]; p.c = (const float*)d_in[1]; p.pos = (const int*)d_in[2]; p.w_ada = (const float*)d_in[3]; p.b_ada = (const float*)d_in[4]; p.w_in = (const float*)d_in[5];
    p.qng = (const float*)d_in[6]; p.kvng = (const float*)d_in[7]; p.w_uq = (const float*)d_in[8]; p.w_ukv = (const float*)d_in[9]; p.fox_bias = (const float*)d_in[10];
    p.w_branch = (const float*)d_in[11]; p.w_out = (const float*)d_in[12]; p.ln_g = (const float*)d_in[13]; p.ln_b = (const float*)d_in[14];
    p.out = (float*)d_out; p.ws = (unsigned char*)d_ws;
#if PER_PHASE_LAUNCH
    for (int ph = 0; ph < N_PHASES; ++ph) { p.ph_lo = ph; p.ph_hi = ph + 1; hipLaunchKernelGGL(mega, dim3(grid), dim3(512), LDS_BYTES, stream, p); }
#else
    p.ph_lo = 0; p.ph_hi = N_PHASES;
    void* args[] = {&p};
    hipError_t e = hipLaunchCooperativeKernel((const void*)mega, dim3(grid), dim3(512), args, LDS_BYTES, stream);
    if (e != hipSuccess) fprintf(stderr, "kernel_launch: cooperative launch failed: %s (grid %d)\n", hipGetErrorString(e), grid);
#endif
}
```

```cpp
#include <hip/hip_runtime.h>
#include <hip/hip_cooperative_groups.h>
#include <cstdio>
#include <cstdint>
#include <cmath>
namespace cg = cooperative_groups;

#ifndef PER_PHASE_LAUNCH
#define PER_PHASE_LAUNCH 0
#endif

#define LAS __attribute__((address_space(3)))
typedef unsigned short bf16_t;
typedef short bf16x8 __attribute__((ext_vector_type(8)));
typedef float f32x4 __attribute__((ext_vector_type(4)));
typedef float f32x2 __attribute__((ext_vector_type(2)));
typedef float f32x16 __attribute__((ext_vector_type(16)));
typedef unsigned u32x4 __attribute__((ext_vector_type(4)));
typedef unsigned u32x2 __attribute__((ext_vector_type(2)));
typedef __bf16 bf16x2_t __attribute__((ext_vector_type(2)));

constexpr int T = 8192, DM = 2048, SEQ = 2048, NBATCH = 4, NLAYER = 4, DIN = 16200, N1 = 16384;
constexpr float LOG2E = 1.4426950408889634f;
constexpr float ALPHA = 1.681792830507429f;
constexpr int LDS_BYTES = 131072 + 1024;

constexpr size_t al256(size_t x) { return (x + 255) & ~(size_t)255; }
constexpr size_t SZ_BT1 = (size_t)N1 * DM * 2, SZ_BT2Q = (size_t)1536 * 512 * 2, SZ_BT2KV = (size_t)2048 * 256 * 2, SZ_BT3 = (size_t)3 * 2048 * 1024 * 2, SZ_BT4 = (size_t)2048 * 2048 * 2;
constexpr size_t OFF_BT2Q = SZ_BT1, OFF_BT2KV = OFF_BT2Q + SZ_BT2Q, OFF_BT3 = OFF_BT2KV + SZ_BT2KV, OFF_BT4 = OFF_BT3 + SZ_BT3, SZ_WL = OFF_BT4 + SZ_BT4;
constexpr size_t WS_CTR = 0;
constexpr size_t WS_BAR = 256;
constexpr size_t WS_ZERO_BYTES = 256 + 16384;
constexpr size_t WS_W = WS_ZERO_BYTES;
constexpr size_t WS_MOD = al256(WS_W + NLAYER * SZ_WL);
constexpr size_t WS_CS = al256(WS_MOD + (size_t)NLAYER * 4 * 6144 * 4);
constexpr size_t WS_U = al256(WS_CS + (size_t)T * 32 * 8);
constexpr size_t WS_X = al256(WS_U + (size_t)T * DM * 2);
constexpr size_t WS_Y = al256(WS_X + (size_t)T * DM * 4);
constexpr size_t WS_MRG2 = WS_Y;
constexpr size_t WS_CQ = al256(WS_Y + (size_t)T * DM * 4);
constexpr size_t WS_CKV = al256(WS_CQ + (size_t)T * 512 * 2);
constexpr size_t WS_SSQ = al256(WS_CKV + (size_t)T * 256 * 2);
constexpr size_t WS_SG = al256(WS_SSQ + (size_t)T * 16 * 4);
constexpr size_t SZ_TH = (size_t)T * 1024 * 2;
constexpr size_t WS_QB = al256(WS_SG + 3 * SZ_TH), WS_KB = WS_QB + SZ_TH, WS_VBT = WS_KB + SZ_TH, WS_QC = WS_VBT + SZ_TH, WS_KC = WS_QC + SZ_TH, WS_VCT = WS_KC + SZ_TH;
constexpr size_t WS_QAN = WS_VCT + SZ_TH, WS_KAN = WS_QAN + SZ_TH, WS_VAT = WS_KAN + SZ_TH;
constexpr size_t WS_QAR = WS_VAT + SZ_TH;
constexpr size_t WS_KR = al256(WS_QAR + (size_t)T * 512 * 2);
constexpr size_t WS_MISC = al256(WS_KR + (size_t)T * 64 * 2);
constexpr size_t WS_FC = al256(WS_MISC + (size_t)T * 128 * 4);
constexpr size_t WS_MG = al256(WS_FC + (size_t)32 * 2048 * 4);
constexpr size_t WS_YS = al256(WS_MG + (size_t)T * 6144 * 2);
constexpr size_t WS_MACC = al256(WS_YS + 3 * SZ_TH);
constexpr size_t WS_MRG = al256(WS_MACC + (size_t)T * DM * 4);
constexpr size_t WS_END = al256(WS_MRG + (size_t)T * DM * 2);

struct Params {
    const float* x; const float* c; const int* pos; const float* w_ada; const float* b_ada; const float* w_in;
    const float* qng; const float* kvng; const float* w_uq; const float* w_ukv; const float* fox_bias;
    const float* w_branch; const float* w_out; const float* ln_g; const float* ln_b;
    float* out; unsigned char* ws;
    int ph_lo, ph_hi;
};

__device__ __forceinline__ unsigned pk2(float lo, float hi) { f32x2 v = {lo, hi}; bf16x2_t b = __builtin_convertvector(v, bf16x2_t); return __builtin_bit_cast(unsigned, b); }
__device__ __forceinline__ bf16_t f2bf(float x) { return (bf16_t)(pk2(x, 0.f) & 0xffffu); }
__device__ __forceinline__ float bf2f(bf16_t b) { return __uint_as_float(((unsigned)b) << 16); }
__device__ __forceinline__ float wave_sum(float v) {
#pragma unroll
    for (int o = 32; o >= 1; o >>= 1) v += __shfl_xor(v, o);
    return v;
}
__device__ __forceinline__ float sigmoidf_(float x) { return __builtin_amdgcn_rcpf(1.f + __expf(-x)); }
__device__ __forceinline__ float siluf_(float x) { return x * sigmoidf_(x); }
__device__ __forceinline__ float exp2_(float x) { return __builtin_amdgcn_exp2f(x); }
__device__ __forceinline__ float log2_(float x) { return __builtin_amdgcn_logf(x); }
__device__ __forceinline__ float max3_(float a, float b, float c) { float r; asm("v_max3_f32 %0, %1, %2, %3" : "=v"(r) : "v"(a), "v"(b), "v"(c)); return r; }
__device__ __forceinline__ f32x2 pk_sub(f32x2 a, f32x2 b) { f32x2 r; asm("v_pk_add_f32 %0, %1, %2 neg_lo:[0,1] neg_hi:[0,1]" : "=v"(r) : "v"(a), "v"(b)); return r; }
__device__ __forceinline__ f32x2 pk_add(f32x2 a, f32x2 b) { f32x2 r; asm("v_pk_add_f32 %0, %1, %2" : "=v"(r) : "v"(a), "v"(b)); return r; }
__device__ __forceinline__ float swap_max(float x) { auto rr = __builtin_amdgcn_permlane32_swap(__float_as_uint(x), __float_as_uint(x), false, false); return fmaxf(__uint_as_float(rr[0]), __uint_as_float(rr[1])); }
__device__ __forceinline__ float swap_sum(float x) { auto rr = __builtin_amdgcn_permlane32_swap(__float_as_uint(x), __float_as_uint(x), false, false); return __uint_as_float(rr[0]) + __uint_as_float(rr[1]); }
__device__ __forceinline__ float swap_partner(float x, int hh) { auto rr = __builtin_amdgcn_permlane32_swap(__float_as_uint(x), __float_as_uint(x), false, false); return __uint_as_float(hh ? rr[0] : rr[1]); }

__device__ __forceinline__ int my_tid() { int t = threadIdx.x; asm volatile("" : "+v"(t)); return t; }
__device__ __forceinline__ int my_bx() { int b = blockIdx.x; asm volatile("" : "+s"(b)); return b; }
__device__ __forceinline__ int my_G() { int g = gridDim.x; asm volatile("" : "+s"(g)); return g; }
namespace pg8 {
#define PG8_LAS __attribute__((address_space(3)))
constexpr int BM = 256, BK = 64, HALF = 128, HTB = HALF * BK * 2, STAGE_BYTES = 8 * HTB, NXCD = 8, WGM = 8;
__host__ __device__ __forceinline__ int lds_byte(int r, int c) { const int st = (r >> 4) * 2 + (c >> 5), rr = r & 15, cc = c & 31, ob = rr * 64 + cc * 2; return st * 1024 + (ob ^ (((ob >> 9) & 1) << 5)); }
__host__ __device__ __forceinline__ void stage_rc(int b, int& R, int& C) { const int st = b / 1024, sb = b % 1024, swz = sb ^ (((sb >> 9) & 1) << 5); R = (st >> 1) * 16 + swz / 64; C = (st & 1) * 32 + (swz % 64) / 2; }
__host__ __device__ __forceinline__ int perm32(int rho) { const int n = rho >> 4, i = rho & 15; return 8 * (i >> 2) + 4 * n + (i & 3); }
struct Unit { int pm, pn; };
struct Gemm { const bf16_t* A; const bf16_t* Bt; int M, N, K; };
struct StaticOrder {
    int nM, nN, nwg, G, c;
    __host__ __device__ void init(int M, int N, int G_, int c_) { nM = M / BM; nN = N / BM; nwg = nM * nN; G = G_; c = c_; }
    __host__ __device__ bool next(int i, Unit& u) const {
        const long L = (long)i * G + c; if (L >= nwg) return false;
        int wgid = (int)L; { const int q = nwg / NXCD, r = nwg % NXCD, xcd = wgid % NXCD, off = wgid / NXCD; wgid = (xcd < r ? xcd * (q + 1) : r * (q + 1) + (xcd - r) * q) + off; }
        const int nig = WGM * nN, gid = wgid / nig, fm = gid * WGM, gsz = (nM - fm) < WGM ? (nM - fm) : WGM;
        u.pm = fm + ((wgid % nig) % gsz); u.pn = (wgid % nig) / gsz; return true;
    }
    __device__ __forceinline__ void a_ready(const Unit&) const {}
    __device__ __forceinline__ void done(const Unit&) const {}
};
struct BranchOrder {
    StaticOrder so;
    __device__ bool next(int i, Unit& u) const { Unit t; if (!so.next(i / 3, t)) return false; const int n = i % 3; u.pm = n * 32 + t.pm; u.pn = n * 8 + t.pn; return true; }
    __device__ __forceinline__ void a_ready(const Unit&) const {}
    __device__ __forceinline__ void done(const Unit&) const {}
};

template <class Epi, class Sched, bool ALIGN_EPI = false, bool SP2 = false>
__device__ __forceinline__ void gemm_phase(PG8_LAS unsigned char* lds, const Gemm g, const Sched& S, const Epi& E) {
    const int tid = my_tid(), wid = __builtin_amdgcn_readfirstlane(tid >> 6), lane = tid & 63, wr = wid >> 2, wc = wid & 3, fr = lane & 15, fq = lane >> 4;
    const int K = g.K, nt = K / BK;
    unsigned voffA[2], voffB[2];
#pragma unroll
    for (int i = 0; i < 2; ++i) { int R, C; stage_rc(tid * 16 + i * 8192, R, C); const int Rb = Epi::PERM ? ((R & ~31) + perm32(R & 31)) : R;
        voffA[i] = (unsigned)(R * K + C) * 2u; voffB[i] = (unsigned)(Rb * K + C) * 2u; }
    const size_t kstep = (size_t)(BK * 2);
    const size_t hstep = (size_t)HALF * K * 2;
    const size_t tstep = 2 * hstep;
    const unsigned ldsw = (unsigned)wid * 1024u;
    const int aoff = lds_byte(wr * 64 + fr, fq * 8), boff = lds_byte(wc * 32 + fr, fq * 8);
#define PG8_SA(b, h) (((b) * 2 + (h)) * HTB)
#define PG8_SB(b, h) ((4 + (b) * 2 + (h)) * HTB)
#define PG8_STAGE(bufoff, gbase, voff) do { _Pragma("unroll") for (int _i = 0; _i < 2; ++_i) \
        __builtin_amdgcn_global_load_lds((const unsigned*)((const char*)(gbase) + (voff)[_i]), (PG8_LAS unsigned*)(lds + (bufoff) + ldsw + _i * 8192), 16, 0, 0); } while (0)
#define PG8_LDA(dst, b, h) do { _Pragma("unroll") for (int m = 0; m < 4; ++m) _Pragma("unroll") for (int k = 0; k < 2; ++k) dst[m][k] = *(const PG8_LAS bf16x8*)(lds + PG8_SA(b, h) + aoff + m * 2048 + k * 1024); } while (0)
#define PG8_LDB(dst, b, h) do { _Pragma("unroll") for (int n = 0; n < 2; ++n) _Pragma("unroll") for (int k = 0; k < 2; ++k) dst[n][k] = *(const PG8_LAS bf16x8*)(lds + PG8_SB(b, h) + boff + n * 2048 + k * 1024); } while (0)
#define PG8_MMA(ai, bj, At, Bt) do { __builtin_amdgcn_s_setprio(1); _Pragma("unroll") for (int m = 0; m < 4; ++m) _Pragma("unroll") for (int n = 0; n < 2; ++n) _Pragma("unroll") for (int k = 0; k < 2; ++k) \
        acc[ai][bj][m][n] = __builtin_amdgcn_mfma_f32_16x16x32_bf16(Bt[n][k], At[m][k], acc[ai][bj][m][n], 0, 0, 0); __builtin_amdgcn_s_setprio(0); } while (0)
#define PG8_WAIT_V(n) asm volatile("s_waitcnt vmcnt(" #n ")" ::: "memory")
#define PG8_WAIT_L(n) asm volatile("s_waitcnt lgkmcnt(" #n ")" ::: "memory")
#define PG8_BAR __builtin_amdgcn_s_barrier()
#define PG8_SCHED __builtin_amdgcn_sched_barrier(0)
    Unit cur, nxt; int ui = 0;
    if (!S.next(0, cur)) return;
    f32x4 acc[2][2][4][2];
#pragma unroll
    for (int a = 0; a < 2; ++a)
#pragma unroll
        for (int b = 0; b < 2; ++b)
#pragma unroll
            for (int m = 0; m < 4; ++m)
#pragma unroll
                for (int n = 0; n < 2; ++n) acc[a][b][m][n] = (f32x4){0.f, 0.f, 0.f, 0.f};
    bf16x8 At[4][2], B0[2][2], B1[2][2];
    const char* cA = (const char*)g.A + (size_t)cur.pm * tstep; const char* cB = (const char*)g.Bt + (size_t)cur.pn * tstep;
    S.a_ready(cur);
    if constexpr (SP2) {
        PG8_STAGE(PG8_SB(0, 0), cB, voffB); PG8_STAGE(PG8_SB(0, 1), cB + hstep, voffB); PG8_STAGE(PG8_SA(0, 0), cA, voffA); PG8_STAGE(PG8_SA(0, 1), cA + hstep, voffA);
        if (wr == 1) PG8_BAR;
        PG8_WAIT_V(2); PG8_BAR;
        PG8_STAGE(PG8_SB(1, 0), cB + kstep, voffB); PG8_STAGE(PG8_SA(1, 0), cA + kstep, voffA); PG8_STAGE(PG8_SB(1, 1), cB + hstep + kstep, voffB);
        PG8_WAIT_V(6); PG8_BAR;
    } else {
        PG8_STAGE(PG8_SB(0, 0), cB, voffB); PG8_STAGE(PG8_SA(0, 0), cA, voffA); PG8_STAGE(PG8_SB(0, 1), cB + hstep, voffB); PG8_STAGE(PG8_SA(0, 1), cA + hstep, voffA);
        if (wr == 1) PG8_BAR;
        PG8_WAIT_V(4); PG8_BAR;
        PG8_STAGE(PG8_SB(1, 0), cB + kstep, voffB); PG8_STAGE(PG8_SA(1, 0), cA + kstep, voffA); PG8_STAGE(PG8_SB(1, 1), cB + hstep + kstep, voffB);
        PG8_WAIT_V(6); PG8_BAR;
    }
    for (;;) {
        const bool has_next = S.next(ui + 1, nxt);
        const char* nA = has_next ? (const char*)g.A + (size_t)nxt.pm * tstep : cA; const char* nB = has_next ? (const char*)g.Bt + (size_t)nxt.pn * tstep : cB;
#pragma unroll 1
        for (int t = 0; t < nt; t += 2) {
            const bool last = (t == nt - 2);
            const char* a1 = cA + (size_t)(t + 1) * kstep;
            const char* a2 = last ? nA : cA + (size_t)(t + 2) * kstep; const char* b2 = last ? nB : cB + (size_t)(t + 2) * kstep;
            const char* a3 = a2 + kstep; const char* b3 = b2 + kstep;
            if (last && has_next) S.a_ready(nxt);
            if constexpr (SP2) {
            PG8_LDB(B0, 0, 0); PG8_LDB(B1, 0, 1); PG8_SCHED; PG8_LDA(At, 0, 0); PG8_STAGE(PG8_SA(1, 1), a1 + hstep, voffA);
            PG8_WAIT_V(8); PG8_WAIT_L(0); PG8_BAR; PG8_MMA(0, 0, At, B0); PG8_MMA(0, 1, At, B1); PG8_BAR; PG8_SCHED;
            PG8_LDA(At, 0, 1); PG8_STAGE(PG8_SB(0, 0), b2, voffB); PG8_STAGE(PG8_SB(0, 1), b2 + hstep, voffB); PG8_STAGE(PG8_SA(0, 0), a2, voffA);
            PG8_WAIT_V(8); PG8_WAIT_L(0); PG8_BAR; PG8_MMA(1, 0, At, B0); PG8_MMA(1, 1, At, B1); PG8_BAR; PG8_SCHED;
            PG8_LDB(B0, 1, 0); PG8_LDB(B1, 1, 1); PG8_SCHED; PG8_LDA(At, 1, 0); PG8_STAGE(PG8_SA(0, 1), a2 + hstep, voffA);
            PG8_WAIT_V(8); PG8_WAIT_L(0); PG8_BAR; PG8_MMA(0, 0, At, B0); PG8_MMA(0, 1, At, B1); PG8_BAR; PG8_SCHED;
            PG8_LDA(At, 1, 1); PG8_STAGE(PG8_SB(1, 0), b3, voffB); PG8_STAGE(PG8_SB(1, 1), b3 + hstep, voffB); PG8_STAGE(PG8_SA(1, 0), a3, voffA);
            PG8_WAIT_V(8); PG8_WAIT_L(0); PG8_BAR; PG8_MMA(1, 0, At, B0); PG8_MMA(1, 1, At, B1); PG8_BAR; PG8_SCHED;
            } else {
            PG8_LDB(B0, 0, 0); PG8_SCHED; PG8_LDA(At, 0, 0); PG8_STAGE(PG8_SA(1, 1), a1 + hstep, voffA);
            PG8_WAIT_L(8); PG8_BAR; PG8_WAIT_L(0); PG8_MMA(0, 0, At, B0); PG8_BAR; PG8_SCHED;
            PG8_LDB(B1, 0, 1); PG8_STAGE(PG8_SB(0, 0), b2, voffB);
            PG8_BAR; PG8_WAIT_L(0); PG8_MMA(0, 1, At, B1); PG8_BAR;
            PG8_LDA(At, 0, 1); PG8_STAGE(PG8_SA(0, 0), a2, voffA);
            PG8_BAR; PG8_WAIT_L(0); PG8_MMA(1, 0, At, B0); PG8_BAR; PG8_SCHED;
            PG8_STAGE(PG8_SB(0, 1), b2 + hstep, voffB);
            PG8_WAIT_V(6); PG8_BAR; PG8_MMA(1, 1, At, B1); PG8_BAR;
            PG8_LDB(B0, 1, 0); PG8_SCHED; PG8_LDA(At, 1, 0); PG8_STAGE(PG8_SA(0, 1), a2 + hstep, voffA);
            PG8_WAIT_L(8); PG8_BAR; PG8_WAIT_L(0); PG8_MMA(0, 0, At, B0); PG8_BAR; PG8_SCHED;
            PG8_LDB(B1, 1, 1); PG8_STAGE(PG8_SB(1, 0), b3, voffB);
            PG8_BAR; PG8_WAIT_L(0); PG8_MMA(0, 1, At, B1); PG8_BAR;
            PG8_LDA(At, 1, 1); PG8_STAGE(PG8_SA(1, 0), a3, voffA);
            PG8_BAR; PG8_WAIT_L(0); PG8_MMA(1, 0, At, B0); PG8_BAR; PG8_SCHED;
            PG8_STAGE(PG8_SB(1, 1), b3 + hstep, voffB);
            PG8_WAIT_V(6); PG8_BAR; PG8_MMA(1, 1, At, B1); PG8_BAR;
            }
        }
        if constexpr (ALIGN_EPI) { if (wr == 0) PG8_BAR; }
        E(acc, cur, wr, wc, fr, fq); S.done(cur);
        if (!has_next) break;
        if (!E.keep_acc(cur)) {
#pragma unroll
        for (int a = 0; a < 2; ++a)
#pragma unroll
            for (int b = 0; b < 2; ++b)
#pragma unroll
                for (int m = 0; m < 4; ++m)
#pragma unroll
                    for (int n = 0; n < 2; ++n) acc[a][b][m][n] = (f32x4){0.f, 0.f, 0.f, 0.f};
        }
        cur = nxt; cA = nA; cB = nB; ++ui;
        if constexpr (ALIGN_EPI) { if (wr == 1) PG8_BAR; }
    }
    PG8_WAIT_V(0);
    if constexpr (!ALIGN_EPI) { if (wr == 0) PG8_BAR; }
    PG8_BAR;
#undef PG8_SA
#undef PG8_SB
#undef PG8_STAGE
#undef PG8_LDA
#undef PG8_LDB
#undef PG8_MMA
#undef PG8_WAIT_V
#undef PG8_WAIT_L
#undef PG8_BAR
#undef PG8_SCHED
}
}

typedef const f32x4 (&AccRef)[2][2][4][2];
typedef f32x4 (&AccMut)[2][2][4][2];

template <int ACT> __device__ __forceinline__ void store_bf16_tile(AccRef acc, bf16_t* base, int ld, int row0, int cl0) {
#pragma unroll
    for (int ai = 0; ai < 2; ++ai)
#pragma unroll
        for (int m = 0; m < 4; ++m) { bf16_t* rp = base + (size_t)(row0 + ai * 128 + m * 16) * ld + cl0;
#pragma unroll
            for (int bj = 0; bj < 2; ++bj) { f32x4 v0 = acc[ai][bj][m][0], v1 = acc[ai][bj][m][1];
                if (ACT == 1) {
#pragma unroll
                    for (int j = 0; j < 4; ++j) { v0[j] = siluf_(v0[j]); v1[j] = siluf_(v1[j]); } }
                if (ACT == 2) {
#pragma unroll
                    for (int j = 0; j < 4; ++j) { v0[j] = sigmoidf_(v0[j]); v1[j] = sigmoidf_(v1[j]); } }
                u32x4 w; w.x = pk2(v0[0], v0[1]); w.y = pk2(v0[2], v0[3]); w.z = pk2(v1[0], v1[1]); w.w = pk2(v1[2], v1[3]);
                *(u32x4*)(rp + bj * 128) = w; } }
}
__device__ __forceinline__ void store_vt_tile(AccRef acc, bf16_t* VT, int h0, int row0, int cl0, const float* rscale) {
#pragma unroll
    for (int ai = 0; ai < 2; ++ai)
#pragma unroll
        for (int m = 0; m < 4; ++m) { const int row = row0 + ai * 128 + m * 16; const int b = row >> 11, s = row & 2047; const float rs = rscale ? rscale[ai * 4 + m] : 1.f;
#pragma unroll
            for (int bj = 0; bj < 2; ++bj) { const unsigned po = (unsigned)(((b * 8 + h0 + bj) * 128 + cl0) * 2048 + s);
#pragma unroll
                for (int n = 0; n < 2; ++n)
#pragma unroll
                    for (int j = 0; j < 4; ++j) VT[po + (unsigned)((4 * n + j) * 2048)] = f2bf(acc[ai][bj][m][n][j] * rs); }
            asm volatile("" ::: "memory"); }
}

struct Epi1 {
    static constexpr bool PERM = true;
    __device__ __forceinline__ bool keep_acc(const pg8::Unit&) const { return false; }
    unsigned char* ws;
    __device__ __forceinline__ void operator()(AccRef acc, const pg8::Unit& u, int wr, int wc, int fr, int fq) const {
        const int pn = (13 * u.pn) & 63, row0 = u.pm * 256 + wr * 64 + fr, cl0 = wc * 32 + 8 * fq;
        if (pn < 3) {
            bf16_t* base; int ld, slot;
            if (pn < 2) { base = (bf16_t*)(ws + WS_CQ) + pn * 256; ld = 512; slot = pn * 4 + wc; } else { base = (bf16_t*)(ws + WS_CKV); ld = 256; slot = 8 + wc; }
            float* ssq = (float*)(ws + WS_SSQ);
#pragma unroll
            for (int ai = 0; ai < 2; ++ai)
#pragma unroll
                for (int m = 0; m < 4; ++m) { const int row = row0 + ai * 128 + m * 16; bf16_t* rp = base + (size_t)row * ld + cl0; float ss = 0.f;
#pragma unroll
                    for (int bj = 0; bj < 2; ++bj) { const f32x4 v0 = acc[ai][bj][m][0], v1 = acc[ai][bj][m][1];
                        ss += (v0[0] * v0[0] + v0[1] * v0[1]) + (v0[2] * v0[2] + v0[3] * v0[3]) + (v1[0] * v1[0] + v1[1] * v1[1]) + (v1[2] * v1[2] + v1[3] * v1[3]);
                        u32x4 w; w.x = pk2(v0[0], v0[1]); w.y = pk2(v0[2], v0[3]); w.z = pk2(v1[0], v1[1]); w.w = pk2(v1[2], v1[3]);
                        *(u32x4*)(rp + bj * 128) = w; }
                    ss += __shfl_xor(ss, 16); ss += __shfl_xor(ss, 32);
                    if (fq == 0) ssq[(size_t)row * 16 + slot] = ss; }
        } else if (pn == 63) {
            float* misc = (float*)(ws + WS_MISC);
#pragma unroll
            for (int ai = 0; ai < 2; ++ai)
#pragma unroll
                for (int m = 0; m < 4; ++m) { float* rp = misc + (size_t)(row0 + ai * 128 + m * 16) * 128 + cl0;
                    *(f32x4*)(rp) = acc[ai][0][m][0]; *(f32x4*)(rp + 4) = acc[ai][0][m][1]; }
        } else if (pn >= 39) {
            store_bf16_tile<2>(acc, (bf16_t*)(ws + WS_MG) + (pn - 39) * 256, 6144, row0, cl0);
        } else {
            const int seg = (pn - 3) >> 2, ct = (pn - 3) & 3;
            if (seg == 0 || seg == 4 || seg == 8) store_bf16_tile<1>(acc, (bf16_t*)(ws + WS_SG) + (size_t)(seg >> 2) * T * 1024 + ct * 256, 1024, row0, cl0);
            else if (seg == 3) store_vt_tile(acc, (bf16_t*)(ws + WS_VBT), ct * 2, row0, cl0, nullptr);
            else if (seg == 7) store_vt_tile(acc, (bf16_t*)(ws + WS_VCT), ct * 2, row0, cl0, nullptr);
            else { const size_t off = seg == 1 ? WS_QB : seg == 2 ? WS_KB : seg == 5 ? WS_QC : WS_KC; store_bf16_tile<0>(acc, (bf16_t*)(ws + off) + ct * 256, 1024, row0, cl0); }
        }
    }
};

template <int WHICH  > struct Epi2 {
    static constexpr bool PERM = true;
    __device__ __forceinline__ bool keep_acc(const pg8::Unit&) const { return false; }
    unsigned char* ws;
    __device__ __forceinline__ float rstd(int row) const {
        const float* ssq = (const float*)(ws + WS_SSQ) + (size_t)row * 16 + (WHICH ? 8 : 0);
        const f32x4 a = *(const f32x4*)ssq; float s = (a[0] + a[1]) + (a[2] + a[3]);
        if (WHICH == 0) { const f32x4 b = *(const f32x4*)(ssq + 4); s += (b[0] + b[1]) + (b[2] + b[3]); }
        return rsqrtf(s * (WHICH ? (1.f / 256.f) : (1.f / 512.f)) + 1e-6f);
    }
    __device__ __forceinline__ void operator()(AccRef acc, const pg8::Unit& u, int wr, int wc, int fr, int fq) const {
        const int pn = u.pn, row0 = u.pm * 256 + wr * 64 + fr, cl0 = wc * 32 + 8 * fq;
        if (pn < 4) {
            bf16_t* base = (bf16_t*)(ws + (WHICH ? WS_KAN : WS_QAN)) + pn * 256;
#pragma unroll
            for (int ai = 0; ai < 2; ++ai)
#pragma unroll
                for (int m = 0; m < 4; ++m) { const int row = row0 + ai * 128 + m * 16; bf16_t* rp = base + (size_t)row * 1024 + cl0; const float r = rstd(row);
#pragma unroll
                    for (int bj = 0; bj < 2; ++bj) { const f32x4 v0 = acc[ai][bj][m][0] * r, v1 = acc[ai][bj][m][1] * r;
                        u32x4 w; w.x = pk2(v0[0], v0[1]); w.y = pk2(v0[2], v0[3]); w.z = pk2(v1[0], v1[1]); w.w = pk2(v1[2], v1[3]);
                        *(u32x4*)(rp + bj * 128) = w; }
                    asm volatile("" ::: "memory"); }
        } else if (WHICH == 1) {
            bf16_t* VT = (bf16_t*)(ws + WS_VAT); const int h0 = (pn - 4) * 2;
#pragma unroll
            for (int ai = 0; ai < 2; ++ai)
#pragma unroll
                for (int m = 0; m < 4; ++m) { const int row = row0 + ai * 128 + m * 16; const int b = row >> 11, s = row & 2047; const float rs = rstd(row);
#pragma unroll
                    for (int bj = 0; bj < 2; ++bj) { const unsigned po = (unsigned)(((b * 8 + h0 + bj) * 128 + cl0) * 2048 + s);
#pragma unroll
                        for (int n = 0; n < 2; ++n)
#pragma unroll
                            for (int j = 0; j < 4; ++j) VT[po + (unsigned)((4 * n + j) * 2048)] = f2bf(acc[ai][bj][m][n][j] * rs); }
                    asm volatile("" ::: "memory"); }
        } else {
            bf16_t* base = (bf16_t*)(ws + WS_QAR) + (pn - 4) * 256;
            const f32x2* cs = (const f32x2*)(ws + WS_CS);
#pragma unroll
            for (int ai = 0; ai < 2; ++ai)
#pragma unroll
                for (int m = 0; m < 4; ++m) { const int row = row0 + ai * 128 + m * 16; bf16_t* rp = base + (size_t)row * 512 + cl0; const float r = rstd(row);
#pragma unroll
                    for (int bj = 0; bj < 2; ++bj) { const int j0 = ((bj * 128 + cl0) & 63) >> 1;
                        const f32x4 c01 = *(const f32x4*)(cs + (size_t)row * 32 + j0), c23 = *(const f32x4*)(cs + (size_t)row * 32 + j0 + 2);
                        const f32x4 v0 = acc[ai][bj][m][0] * r, v1 = acc[ai][bj][m][1] * r;
                        u32x4 w;
                        w.x = pk2(v0[0] * c01[0] - v0[1] * c01[1], v0[1] * c01[0] + v0[0] * c01[1]);
                        w.y = pk2(v0[2] * c01[2] - v0[3] * c01[3], v0[3] * c01[2] + v0[2] * c01[3]);
                        w.z = pk2(v1[0] * c23[0] - v1[1] * c23[1], v1[1] * c23[0] + v1[0] * c23[1]);
                        w.w = pk2(v1[2] * c23[2] - v1[3] * c23[3], v1[3] * c23[2] + v1[2] * c23[3]);
                        *(u32x4*)(rp + bj * 128) = w; }
                    asm volatile("" ::: "memory"); }
        }
    }
};

__device__ __forceinline__ void unpack_gate(const u32x4 gw, f32x4& g0, f32x4& g1) {
    g0[0] = __uint_as_float(gw.x << 16); g0[1] = __uint_as_float(gw.x & 0xffff0000u); g0[2] = __uint_as_float(gw.y << 16); g0[3] = __uint_as_float(gw.y & 0xffff0000u);
    g1[0] = __uint_as_float(gw.z << 16); g1[1] = __uint_as_float(gw.z & 0xffff0000u); g1[2] = __uint_as_float(gw.w << 16); g1[3] = __uint_as_float(gw.w & 0xffff0000u);
}
struct Epi3 {
    static constexpr bool PERM = true;
    __device__ __forceinline__ bool keep_acc(const pg8::Unit& u) const { return (u.pm >> 5) < 2; }
    unsigned char* ws;
    __device__ __forceinline__ void operator()(AccMut acc, const pg8::Unit& u, int wr, int wc, int fr, int fq) const {
        const int n = u.pm >> 5, pm = u.pm & 31, pn = u.pn & 7;
        const int row0 = pm * 256 + wr * 64 + fr, col0 = pn * 256 + wc * 32 + 8 * fq;
        const bf16_t* mg = (const bf16_t*)(ws + WS_MG) + n * 2048; bf16_t* mrg = (bf16_t*)(ws + WS_MRG);
#pragma unroll
        for (int ai = 0; ai < 2; ++ai)
#pragma unroll
            for (int m = 0; m < 4; ++m) { const int row = row0 + ai * 128 + m * 16;
#pragma unroll
                for (int bj = 0; bj < 2; ++bj) { const int col = col0 + bj * 128;
                    f32x4 g0, g1; unpack_gate(*(const u32x4*)(mg + (size_t)row * 6144 + col), g0, g1);
#pragma unroll
                    for (int j = 0; j < 4; ++j) { g0[j] = fmaxf(g0[j], 1e-20f); g1[j] = fmaxf(g1[j], 1e-20f); }
                    if (n < 2) { f32x4 h0, h1; unpack_gate(*(const u32x4*)(mg + (size_t)row * 6144 + 2048 + col), h0, h1);
#pragma unroll
                        for (int j = 0; j < 4; ++j) { g0[j] *= __builtin_amdgcn_rcpf(fmaxf(h0[j], 1e-20f)); g1[j] *= __builtin_amdgcn_rcpf(fmaxf(h1[j], 1e-20f)); }
                        acc[ai][bj][m][0] *= g0; acc[ai][bj][m][1] *= g1;
                    } else {
                        const f32x4 v0 = acc[ai][bj][m][0] * g0, v1 = acc[ai][bj][m][1] * g1;
                        u32x4 w; w.x = pk2(v0[0], v0[1]); w.y = pk2(v0[2], v0[3]); w.z = pk2(v1[0], v1[1]); w.w = pk2(v1[2], v1[3]); *(u32x4*)(mrg + (size_t)row * 2048 + col) = w; } } }
    }
};

struct Epi4 {
    static constexpr bool PERM = true;
    __device__ __forceinline__ bool keep_acc(const pg8::Unit&) const { return false; }
    bf16_t* O;
    __device__ __forceinline__ void operator()(AccRef acc, const pg8::Unit& u, int wr, int wc, int fr, int fq) const {
        store_bf16_tile<0>(acc, O + u.pn * 256, 2048, u.pm * 256 + wr * 64 + fr, wc * 32 + 8 * fq);
    }
};

__device__ __forceinline__ int map_bt1(int n, float& sc) {
    n = (((13 * (n >> 8)) & 63) << 8) | (n & 255);
    sc = 1.f;
    if (n < 768) return n;
    if (n < 1792) return 832 + (n - 768);
    if (n < 2816) { sc = LOG2E * 0.08838834764831845f; return 1856 + (n - 1792); }
    if (n < 3840) return 2880 + (n - 2816);
    if (n < 4864) return 3904 + (n - 3840);
    if (n < 5888) return 4936 + (n - 4864);
    if (n < 6912) { sc = LOG2E * 0.08838834764831845f; return 5960 + (n - 5888); }
    if (n < 7936) return 6984 + (n - 6912);
    if (n < 8960) return 8008 + (n - 7936);
    if (n < 9984) return 9032 + (n - 8960);
    if (n < 16128) return 10056 + (n - 9984);
    const int r = n - 16128;
    if (r < 64) return 768 + 32 * (r & 1) + (r >> 1);
    if (r < 72) return 4928 + (r - 64);
    return -1;
}
constexpr int CT_BT1 = 128 * 16, CT_BT2Q = 12 * 4, CT_BT2KV = 16 * 2, CT_BT3 = 3 * 16 * 8, CT_BT4 = 16 * 16, CT_LAYER = CT_BT1 + CT_BT2Q + CT_BT2KV + CT_BT3 + CT_BT4;
constexpr int NJ_MOD = 192, NJ_CS = 64, NJ_CONV = NLAYER * CT_LAYER, NJ_TOTAL = NJ_MOD + NJ_CS + NJ_CONV;

__device__ __forceinline__ void conv_tile(const Params& P, int job, LAS unsigned char* lds) {
    const int tid = my_tid();
    const int l = job / CT_LAYER; int r = job % CT_LAYER;
    unsigned char* wl = P.ws + WS_W + (size_t)l * SZ_WL;
    int kind, nt, kt; const float* src; int ld; bf16_t* dst; int Kd; const float* gain = nullptr; float gsc = 1.f;
    if (r < CT_BT1) { kind = 0; nt = r >> 4; kt = r & 15; src = P.w_in + (size_t)l * DM * DIN; ld = DIN; dst = (bf16_t*)wl; Kd = 2048; }
    else if ((r -= CT_BT1) < CT_BT2Q) { kind = 1; nt = r >> 2; kt = r & 3; src = P.w_uq + (size_t)l * 512 * 1536; ld = 1536; dst = (bf16_t*)(wl + OFF_BT2Q); Kd = 512; gain = P.qng + l * 512; gsc = LOG2E * 0.07216878364870323f; }
    else if ((r -= CT_BT2Q) < CT_BT2KV) { kind = 2; nt = r >> 1; kt = r & 1; src = P.w_ukv + (size_t)l * 256 * 2048; ld = 2048; dst = (bf16_t*)(wl + OFF_BT2KV); Kd = 256; gain = P.kvng + l * 256; }
    else if ((r -= CT_BT2KV) < CT_BT3) { kind = 3; const int br = r >> 7; r &= 127; nt = r >> 3; kt = r & 7; src = P.w_branch + ((size_t)l * 3 + br) * 1024 * 2048; ld = 2048; dst = (bf16_t*)(wl + OFF_BT3) + (size_t)br * 2048 * 1024; Kd = 1024; }
    else { r -= CT_BT3; kind = 4; nt = r >> 4; kt = r & 15; src = P.w_out + (size_t)l * 2048 * 2048; ld = 2048; dst = (bf16_t*)(wl + OFF_BT4); Kd = 2048; }
    const int nl = tid & 127, kb = tid >> 7, n = nt * 128 + nl;
    int sc_col; float sc = 1.f;
    if (kind == 0) sc_col = map_bt1(n, sc);
    else if (kind == 1) { if (n < 1024) sc_col = (n >> 7) * 192 + (n & 127); else { const int q = n - 1024, h = q >> 6, rr = q & 63; sc_col = h * 192 + 128 + 32 * (rr & 1) + (rr >> 1); } sc = gsc; }
    else if (kind == 2) { if (n < 1024) sc_col = (n >> 7) * 256 + (n & 127); else { const int q = n - 1024; sc_col = (q >> 7) * 256 + 128 + (q & 127); } }
    else sc_col = n;
    LAS bf16_t* tl = (LAS bf16_t*)lds;
    const float* sp = src + (size_t)(kt * 128 + kb) * ld + (sc_col < 0 ? 0 : sc_col);
    float v[32];
#pragma unroll
    for (int i = 0; i < 32; ++i) v[i] = (sc_col >= 0) ? __builtin_nontemporal_load(sp + (size_t)(4 * i) * ld) : 0.f;
#pragma unroll
    for (int i = 0; i < 32; ++i) { float g = sc; if (gain) g *= gain[kt * 128 + kb + 4 * i]; tl[nl * 130 + kb + 4 * i] = f2bf(v[i] * g); }
    __syncthreads();
    const int nr = tid >> 2, kc = tid & 3;
    const LAS unsigned* rp = (const LAS unsigned*)(lds + (nr * 130 + kc * 32) * 2);
    bf16_t* dp = dst + (size_t)(nt * 128 + nr) * Kd + kt * 128 + kc * 32;
#pragma unroll
    for (int q = 0; q < 4; ++q) { u32x4 w; w.x = rp[4 * q]; w.y = rp[4 * q + 1]; w.z = rp[4 * q + 2]; w.w = rp[4 * q + 3]; *(u32x4*)(dp + 8 * q) = w; }
}

__device__ __forceinline__ void mod_job(const Params& P, int job, LAS unsigned char* lds) {
    const int tid = my_tid(), l = job / 48, ct = job % 48;
    LAS float* cl = (LAS float*)lds;
    LAS float* part = (LAS float*)(lds + 32768);
    for (int i = tid; i < 4 * 2048; i += 512) cl[i] = P.c[i];
    __syncthreads();
    const int col = ct * 128 + (tid & 127), kg = tid >> 7;
    const float* wp = P.w_ada + (size_t)l * 2048 * 6144 + (size_t)(kg * 512) * 6144 + col;
    float a0 = 0.f, a1 = 0.f, a2 = 0.f, a3 = 0.f;
    for (int k = 0; k < 512; k += 8) {
        float w[8];
#pragma unroll
        for (int j = 0; j < 8; ++j) w[j] = __builtin_nontemporal_load(wp + (size_t)(k + j) * 6144);
#pragma unroll
        for (int j = 0; j < 8; ++j) { const int kk = kg * 512 + k + j; a0 += cl[kk] * w[j]; a1 += cl[2048 + kk] * w[j]; a2 += cl[4096 + kk] * w[j]; a3 += cl[6144 + kk] * w[j]; }
    }
    part[(kg * 4 + 0) * 128 + (tid & 127)] = a0; part[(kg * 4 + 1) * 128 + (tid & 127)] = a1; part[(kg * 4 + 2) * 128 + (tid & 127)] = a2; part[(kg * 4 + 3) * 128 + (tid & 127)] = a3;
    __syncthreads();
    { const int b = tid >> 7, c = tid & 127; const float s = part[(0 * 4 + b) * 128 + c] + part[(1 * 4 + b) * 128 + c] + part[(2 * 4 + b) * 128 + c] + part[(3 * 4 + b) * 128 + c];
      ((float*)(P.ws + WS_MOD))[((size_t)l * 4 + b) * 6144 + ct * 128 + c] = s + P.b_ada[(size_t)l * 6144 + ct * 128 + c]; }
}

__device__ __forceinline__ void cs_job(const Params& P, int job) {
    f32x2* cs = (f32x2*)(P.ws + WS_CS);
    const int tid = my_tid();
#pragma unroll
    for (int i = 0; i < 8; ++i) { const int idx = job * 4096 + i * 512 + tid; const int tok = idx >> 5, j = idx & 31;
        double pw = 1.0, bs = 0.749894209332456; { if (j & 1) pw *= bs; bs *= bs; if (j & 2) pw *= bs; bs *= bs; if (j & 4) pw *= bs; bs *= bs; if (j & 8) pw *= bs; bs *= bs; if (j & 16) pw *= bs; }
        const float ang = (float)P.pos[tok] * (float)pw;
        double rev = (double)ang * 0.15915494309189535; rev -= __builtin_rint(rev);
        const float rf = (float)rev;
        cs[idx] = (f32x2){__builtin_amdgcn_cosf(rf), __builtin_amdgcn_sinf(rf)}; }
}

__device__ __forceinline__ void phase_prologue(const Params& P, LAS unsigned char* lds, int ci) {
    const int G = my_G(), c = my_bx();
    if (G == 256) {
        static_assert(NJ_MOD == 192 && NJ_CS == 64 && NJ_CONV == 41 * 256 + 9 * 64, "static prologue deal");
        if (c < NJ_MOD) mod_job(P, c, lds); else cs_job(P, c - NJ_MOD);
#pragma unroll 1
        for (int r = 0; r < 41; ++r) { __syncthreads(); conv_tile(P, r * 256 + c, lds); }
        if (c >= NJ_MOD) {
#pragma unroll 1
            for (int j = 0; j < 9; ++j) { __syncthreads(); conv_tile(P, 41 * 256 + (c - NJ_MOD) + 64 * j, lds); }
        }
        __syncthreads();
        return;
    }
    unsigned* ctr = (unsigned*)(P.ws + WS_CTR) + ci * 16;
    LAS int* slot = (LAS int*)(lds + 131072);
    const int tid0 = my_tid();
    for (;;) {
        __syncthreads();
        if (tid0 == 0) *slot = (int)atomicAdd(ctr, 1u);
        __syncthreads();
        const int job = *slot;
        if (job >= NJ_TOTAL) break;
        if (job < NJ_MOD) mod_job(P, job, lds);
        else if (job < NJ_MOD + NJ_CS) cs_job(P, job - NJ_MOD);
        else conv_tile(P, job - NJ_MOD - NJ_CS, lds);
    }
}

__device__ __forceinline__ void row_stats(const f32x4 (&v)[8], float& mean, float& rstd) {
    float s = 0.f;
#pragma unroll
    for (int i = 0; i < 8; ++i) s += (v[i][0] + v[i][1]) + (v[i][2] + v[i][3]);
    mean = wave_sum(s) * (1.f / 2048.f);
    float q = 0.f;
#pragma unroll
    for (int i = 0; i < 8; ++i) { const f32x4 d = v[i] - mean; q += (d[0] * d[0] + d[1] * d[1]) + (d[2] * d[2] + d[3] * d[3]); }
    rstd = rsqrtf(wave_sum(q) * (1.f / 2048.f) + 1e-5f);
}
__device__ __forceinline__ void phase_ln(const Params& P, int l) {
    const int tid = my_tid(), bx = my_bx(), G = my_G();
    const int wid = tid >> 6, lane = tid & 63;
    float* X = (float*)(P.ws + WS_X); bf16_t* U = (bf16_t*)(P.ws + WS_U);
    const float* xsrc = (l <= 1) ? P.x : X;
    const bf16_t* outb = (const bf16_t*)(P.ws + WS_MRG2);
    const float* g = P.ln_g + (size_t)(l > 0 ? l - 1 : 0) * 2048; const float* bb = P.ln_b + (size_t)(l > 0 ? l - 1 : 0) * 2048;
    const float* mod = (const float*)(P.ws + WS_MOD) + (size_t)(l < 4 ? l : 0) * 4 * 6144;
    const float* gate = (const float*)(P.ws + WS_MOD) + (size_t)(l > 0 ? l - 1 : 0) * 4 * 6144 + 4096;
    for (int row = bx * 8 + wid; row < T; row += G * 8) {
        f32x4 v[8];
#pragma unroll
        for (int i = 0; i < 8; ++i) v[i] = *(const f32x4*)(xsrc + (size_t)row * 2048 + (i * 64 + lane) * 4);
        if (l >= 1) {
            const float* gp = gate + (size_t)(row >> 11) * 6144;
#pragma unroll
            for (int i = 0; i < 8; ++i) { const int col = (i * 64 + lane) * 4; const u32x2 ow = *(const u32x2*)(outb + (size_t)row * 2048 + col); const f32x4 gv = *(const f32x4*)(gp + col);
                f32x4 o; o[0] = __uint_as_float(ow.x << 16); o[1] = __uint_as_float(ow.x & 0xffff0000u); o[2] = __uint_as_float(ow.y << 16); o[3] = __uint_as_float(ow.y & 0xffff0000u);
                v[i] = v[i] * ALPHA + gv * o; }
        }
        float mean, rstd; row_stats(v, mean, rstd);
        if (l >= 1) {
            float* dst = (l == 4) ? P.out : X;
#pragma unroll
            for (int i = 0; i < 8; ++i) { const int col = (i * 64 + lane) * 4; const f32x4 gv = *(const f32x4*)(g + col), bv = *(const f32x4*)(bb + col);
                v[i] = (v[i] - mean) * rstd * gv + bv; *(f32x4*)(dst + (size_t)row * 2048 + col) = v[i]; }
            if (l == 4) continue;
            row_stats(v, mean, rstd);
        }
        const float* mp = mod + (size_t)(row >> 11) * 6144;
#pragma unroll
        for (int i = 0; i < 8; ++i) { const int col = (i * 64 + lane) * 4; const f32x4 sh = *(const f32x4*)(mp + col), sc = *(const f32x4*)(mp + 2048 + col);
            const f32x4 uu = (v[i] - mean) * rstd * (sc + 1.f) + sh; u32x2 w; w.x = pk2(uu[0], uu[1]); w.y = pk2(uu[2], uu[3]);
            *(u32x2*)(U + (size_t)row * 2048 + col) = w; }
    }
}

__device__ __forceinline__ void phase_small(const Params& P, int l) {
    const float* misc = (const float*)(P.ws + WS_MISC); const f32x2* cs = (const f32x2*)(P.ws + WS_CS); bf16_t* kr = (bf16_t*)(P.ws + WS_KR);
    const int tid = my_tid(), bx = my_bx(), G = my_G();
    const int rb0 = (G == 256) ? 192 : 0, rnb = G - rb0;
    for (int idx = (bx - rb0) * 512 + tid; idx < T * 32 && bx >= rb0; idx += rnb * 512) { const int tok = idx >> 5, j = idx & 31;
        const f32x2 x = *(const f32x2*)(misc + (size_t)tok * 128 + 2 * j); const f32x2 c = cs[idx];
        *(unsigned*)(kr + (size_t)tok * 64 + 2 * j) = pk2(x[0] * c[0] - x[1] * c[1], x[1] * c[0] + x[0] * c[1]); }
    const int wid = tid >> 6, lane = tid & 63;
    const int fb0 = (G >= 200) ? 192 : 0;
    for (int sid = (bx - fb0) * 8 + wid; sid < 32 && bx >= fb0; sid += G * 8) { const int b = sid >> 3, h = sid & 7; const float bias = P.fox_bias[l * 8 + h];
        float loc[32]; float run = 0.f;
#pragma unroll
        for (int i = 0; i < 32; ++i) { const int s = lane * 32 + i; const float xx = misc[(size_t)(b * 2048 + s) * 128 + 64 + h] + bias;
            const float ls = -(fmaxf(-xx, 0.f) + log1pf(expf(-fabsf(xx)))); run += ls; loc[i] = run; }
        float incl = run;
#pragma unroll
        for (int o = 1; o < 64; o <<= 1) { const float t = __shfl_up(incl, o); if (lane >= o) incl += t; }
        const float excl = incl - run; float* fc = (float*)(P.ws + WS_FC) + (size_t)sid * 2048 + lane * 32;
#pragma unroll
        for (int i = 0; i < 32; ++i) fc[i] = (loc[i] + excl) * LOG2E; }
}

#define MFMA32(a, b, c) __builtin_amdgcn_mfma_f32_32x32x16_bf16((a), (b), (c), 0, 0, 0)
__device__ __forceinline__ bf16x8 pack8(const f32x16& x, int s) {
    u32x4 p;
    if (s == 0) { p.x = pk2(x[0], x[1]); p.y = pk2(x[2], x[3]); p.z = pk2(x[4], x[5]); p.w = pk2(x[6], x[7]); }
    else { p.x = pk2(x[8], x[9]); p.y = pk2(x[10], x[11]); p.z = pk2(x[12], x[13]); p.w = pk2(x[14], x[15]); }
    return __builtin_bit_cast(bf16x8, p);
}
__device__ __forceinline__ float exp2_negabs(float x) { float r; asm("v_exp_f32 %0, -|%1|\n\ts_nop 1" : "=v"(r) : "v"(x)); return r; }
__device__ __forceinline__ void sb_sub(f32x16& s, float& carry, const int hh) {
    float w[16];
#pragma unroll
    for (int i = 0; i < 16; ++i) { const float z = s[i]; const float t = log2_(1.f + exp2_negabs(z));
        w[i] = -(__builtin_fmaxf(z, 0.f) + t); }
    const float GA = ((w[0] + w[1]) + (w[2] + w[3])) + ((w[4] + w[5]) + (w[6] + w[7])), GB = ((w[8] + w[9]) + (w[10] + w[11])) + ((w[12] + w[13]) + (w[14] + w[15]));
    const float GAp = swap_partner(GA, hh), GBp = swap_partner(GB, hh);
    float a = carry + (hh == 0 ? GBp : 0.f);
#pragma unroll
    for (int i = 15; i >= 8; --i) { const float wi = w[i]; s[i] = exp2_((s[i] + wi) + a); a += wi; }
    a = carry + GB + GBp + (hh == 0 ? GAp : 0.f);
#pragma unroll
    for (int i = 7; i >= 0; --i) { const float wi = w[i]; s[i] = exp2_((s[i] + wi) + a); a += wi; }
    carry += (GA + GB) + (GAp + GBp);
}

template <int N> __device__ __forceinline__ void at_waitv() {
    if constexpr (N == 0) asm volatile("s_waitcnt vmcnt(0)" ::: "memory");
    else if constexpr (N == 2) asm volatile("s_waitcnt vmcnt(2)" ::: "memory");
    else if constexpr (N == 3) asm volatile("s_waitcnt vmcnt(3)" ::: "memory");
    else if constexpr (N == 4) asm volatile("s_waitcnt vmcnt(4)" ::: "memory");
    else if constexpr (N == 5) asm volatile("s_waitcnt vmcnt(5)" ::: "memory");
    else static_assert(N == 0, "at_waitv: add the count");
}
#define AT_BAR() do { asm volatile("" ::: "memory"); __builtin_amdgcn_s_barrier(); asm volatile("" ::: "memory"); } while (0)
template <int TYPE  >
__device__ __forceinline__ void attn_item(const Params& P, const int b, const int h, const int qt, LAS unsigned char* lds) {
    constexpr int DQK = TYPE == 0 ? 192 : 128, KS = DQK / 16, KROWB = DQK * 2, KREG = 64 * KROWB, VREG = 16384, FREG = TYPE == 1 ? 2048 : 0, SLOT = KREG + VREG + FREG;
    constexpr int NKI = KREG / 8192, NI = NKI + 2 + (TYPE == 1 ? 1 : 0), FLAGS = 126976;
    static_assert(3 * SLOT <= FLAGS && SLOT % 256 == 0, "ring");
    const int tid = my_tid(), wid = __builtin_amdgcn_readfirstlane(tid >> 6), lane = tid & 63, l32 = lane & 31, hh = lane >> 5;
    unsigned char* ws = P.ws;
    const int bh = b * 8 + h;
    const int tq = qt * 256 + wid * 32 + l32;
    const size_t tokq = (size_t)b * 2048 + tq;
    const int NT = 4 * qt + 4, wlast = 4 * qt + (wid >> 1);
    const char* kptr[NKI]; unsigned kstr[NKI]; const char* vptr[2];
    const char* Kbase = (const char*)(ws + (TYPE == 0 ? WS_KAN : TYPE == 1 ? WS_KB : WS_KC));
#pragma unroll
    for (int i = 0; i < NKI; ++i) { const int p = (wid * NKI + i) * 64 + lane;
        if (TYPE == 0) { const int rho = p / 24, cp = p - rho * 24, c = (cp & ~7) | ((cp & 7) ^ ((rho >> 1) & 7));
            if (c < 16) { kptr[i] = Kbase + ((size_t)(b * 2048 + rho) * 1024 + h * 128) * 2 + c * 16; kstr[i] = 131072u; }
            else { kptr[i] = (const char*)(ws + WS_KR) + (size_t)(b * 2048 + rho) * 128 + (c - 16) * 16; kstr[i] = 8192u; }
        } else { const int rho = p >> 4, c = (p & 15) ^ (rho & 15); kptr[i] = Kbase + ((size_t)(b * 2048 + rho) * 1024 + h * 128) * 2 + c * 16; kstr[i] = 131072u; } }
    const char* Vbase = (const char*)(ws + (TYPE == 0 ? WS_VAT : TYPE == 1 ? WS_VBT : WS_VCT));
#pragma unroll
    for (int i = 0; i < 2; ++i) { const int p = (wid * 2 + i) * 64 + lane, r = p >> 3, c = (p & 7) ^ ((r >> 1) & 7); vptr[i] = Vbase + ((size_t)(bh * 128 + r) * 2048) * 2 + c * 16; }
    const char* fptr = (const char*)(ws + WS_FC) + ((size_t)bh * 2048 + lane) * 4;
#define AT_ISSUE(kt, so) do { \
        _Pragma("unroll") for (int i_ = 0; i_ < NKI; ++i_) __builtin_amdgcn_global_load_lds((const unsigned*)(kptr[i_] + (size_t)(kt) * kstr[i_]), (LAS unsigned*)(lds + (so) + (wid * NKI + i_) * 1024), 16, 0, 0); \
        _Pragma("unroll") for (int i_ = 0; i_ < 2; ++i_) __builtin_amdgcn_global_load_lds((const unsigned*)(vptr[i_] + (size_t)(kt) * 128), (LAS unsigned*)(lds + (so) + KREG + (wid * 2 + i_) * 1024), 16, 0, 0); \
        if (TYPE == 1) __builtin_amdgcn_global_load_lds((const unsigned*)(fptr + (size_t)(kt) * 256), (LAS unsigned*)(lds + (so) + KREG + VREG + wid * 256), 4, 0, 0); } while (0)
#define AT_TILE(it_) (TYPE == 2 ? NT - 1 - (it_) : (it_))
    float m_run = -1e30f, l_run = 0.f, carry = 0.f;
    f32x16 o0, o1, o2, o3;
#pragma unroll
    for (int i = 0; i < 16; ++i) { o0[i] = 0.f; o1[i] = 0.f; o2[i] = 0.f; o3[i] = 0.f; }
    const int pl = (l32 & ~12) | ((l32 & 4) << 1) | ((l32 & 8) >> 1);
    const unsigned a0k = (unsigned)(pl * KROWB + ((((TYPE == 0) ? ((pl >> 1) & 7) : (pl & 15)) ^ hh) << 4));
    const unsigned a0v = (unsigned)(KREG + l32 * 128 + ((((l32 >> 1) & 7) ^ hh) << 4));
    const bool ahead = false; bool have_s = false; bool wv_done = false;
    f32x16 s0, s1;
#define AT_KADDR(ks) ((TYPE == 0) ? ((kb_ ^ (unsigned)(32 * ((ks) & 3))) + (unsigned)(((ks) >> 2) * 128)) : (kb_ ^ (unsigned)(32 * (ks))))
#define AT_RK(c) do { _Pragma("unroll") for (int ks = CH * (c); ks < CH * (c) + CH; ++ks) { const unsigned ka = AT_KADDR(ks); kfa[ks] = *(const LAS bf16x8*)(lds + ka); kfb[ks] = *(const LAS bf16x8*)(lds + ka + 32 * KROWB); } } while (0)
#define AT_MK(c) do { _Pragma("unroll") for (int ks = CH * (c); ks < CH * (c) + CH; ++ks) { s0 = MFMA32(kfa[ks], qf[ks], s0); s1 = MFMA32(kfb[ks], qf[ks], s1); } } while (0)
    constexpr int CH = (KS == 12) ? 3 : 4, NC = KS / CH;
#define AT_QK(so_) do { \
        _Pragma("unroll") for (int i_ = 0; i_ < 16; ++i_) { s0[i_] = 0.f; s1[i_] = 0.f; } \
        const unsigned kb_ = a0k + (so_); bf16x8 kfa[KS], kfb[KS]; \
        __builtin_amdgcn_s_setprio(1); AT_RK(0); \
        _Pragma("unroll") for (int c_ = 0; c_ < NC; ++c_) { if (c_ + 1 < NC) { AT_RK(c_ + 1); } __builtin_amdgcn_sched_barrier(0); AT_MK(c_); __builtin_amdgcn_sched_barrier(0); } \
          \
        __builtin_amdgcn_s_setprio(0); asm volatile("s_nop 7\n\ts_nop 7\n\ts_nop 3" : "+v"(s0), "+v"(s1)); } while (0)
    at_waitv<0>(); AT_BAR();
    AT_ISSUE(AT_TILE(0), 0); AT_ISSUE(AT_TILE(1), SLOT);
    bf16x8 qf[KS];
    if (TYPE == 0) {
        const bf16_t* qn = (const bf16_t*)(ws + WS_QAN) + tokq * 1024 + h * 128 + hh * 8; const bf16_t* qr = (const bf16_t*)(ws + WS_QAR) + tokq * 512 + h * 64 + hh * 8;
#pragma unroll
        for (int ks = 0; ks < 8; ++ks) qf[ks] = *(const bf16x8*)(qn + ks * 16);
#pragma unroll
        for (int ks = 8; ks < KS; ++ks) qf[ks] = *(const bf16x8*)(qr + (ks - 8) * 16);
    } else {
        const bf16_t* qp = (const bf16_t*)(ws + (TYPE == 1 ? WS_QB : WS_QC)) + tokq * 1024 + h * 128 + hh * 8;
#pragma unroll
        for (int ks = 0; ks < KS; ++ks) qf[ks] = *(const bf16x8*)(qp + ks * 16);
    }
#pragma unroll
    for (int ks = 0; ks < KS; ++ks) asm volatile("" : "+v"(qf[ks]));
    unsigned so = 0, so2 = 2 * SLOT;
    for (int it = 0; it < NT; ++it) {
        const int kt = AT_TILE(it);
        if (it + 1 < NT) at_waitv<NI>(); else at_waitv<0>();
        AT_BAR();
        if (TYPE == 2 && it > 0) { const LAS int* fl = (const LAS int*)(lds + FLAGS + ((it - 1) & 1) * 32);
            if (fl[0] & fl[1] & fl[2] & fl[3] & fl[4] & fl[5] & fl[6] & fl[7]) break; }
        if (it + 2 < NT) AT_ISSUE(AT_TILE(it + 2), so2);
        if (kt <= wlast && !(TYPE == 2 && wv_done)) {
            if (!have_s) { AT_QK(so); }
            const unsigned vb = a0v + so;
            bf16x8 vf0[4], vf1[4], vf2[4], vf3[4];
#define AT_RV(vf, mb) do { vf[0] = *(const LAS bf16x8*)(lds + vb + (mb) * 4096); vf[1] = *(const LAS bf16x8*)(lds + (vb ^ 32u) + (mb) * 4096); \
                vf[2] = *(const LAS bf16x8*)(lds + (vb ^ 64u) + (mb) * 4096); vf[3] = *(const LAS bf16x8*)(lds + (vb ^ 96u) + (mb) * 4096); } while (0)
            AT_RV(vf0, 0);
            __builtin_amdgcn_sched_barrier(0);
            const bool diag = (kt == wlast);
            const int key0 = kt * 64 + 8 * hh;
            if (TYPE == 2) {
                if (diag) {
#pragma unroll
                    for (int i = 0; i < 16; ++i) { const int key = key0 + 16 * (i >> 3) + (i & 7); if (key >= tq) s0[i] = -1e30f; if (key + 32 >= tq) s1[i] = -1e30f; } }
                sb_sub(s1, carry, hh); sb_sub(s0, carry, hh);
            } else {
                if (TYPE == 1) { const LAS float* fb = (const LAS float*)(lds + so + KREG + VREG + wid * 256) + 8 * hh;
#pragma unroll
                    for (int j = 0; j < 8; ++j) {
                        const f32x2 b0 = *(const LAS f32x2*)(fb + 16 * (j >> 2) + 2 * (j & 3)), b1 = *(const LAS f32x2*)(fb + 32 + 16 * (j >> 2) + 2 * (j & 3));
                        const f32x2 x0 = pk_sub((f32x2){s0[2 * j], s0[2 * j + 1]}, b0), x1 = pk_sub((f32x2){s1[2 * j], s1[2 * j + 1]}, b1);
                        s0[2 * j] = x0[0]; s0[2 * j + 1] = x0[1]; s1[2 * j] = x1[0]; s1[2 * j + 1] = x1[1]; }
                    if (diag) {
#pragma unroll
                        for (int i = 0; i < 16; ++i) { const int key = key0 + 16 * (i >> 3) + (i & 7); if (key > tq) s0[i] = -1e30f; if (key + 32 > tq) s1[i] = -1e30f; } } }
                float mx = m_run;
#pragma unroll
                for (int i = 0; i < 16; ++i) mx = max3_(mx, s0[i], s1[i]);
                asm volatile("s_nop 1" : "+v"(mx));
                const float mnew = swap_max(mx);
                const f32x2 mm = {mnew, mnew}; f32x2 rs2 = {0.f, 0.f};
#pragma unroll
                for (int j = 0; j < 8; ++j) { const f32x2 x0 = pk_sub((f32x2){s0[2 * j], s0[2 * j + 1]}, mm), x1 = pk_sub((f32x2){s1[2 * j], s1[2 * j + 1]}, mm);
                    s0[2 * j] = exp2_(x0[0]); s0[2 * j + 1] = exp2_(x0[1]); s1[2 * j] = exp2_(x1[0]); s1[2 * j + 1] = exp2_(x1[1]);
                    rs2 += (f32x2){s0[2 * j], s0[2 * j + 1]} + (f32x2){s1[2 * j], s1[2 * j + 1]}; }
                const float rs = rs2[0] + rs2[1];
                if (__any(mnew > m_run)) {
                    const float alpha = exp2_(m_run - mnew);
                    l_run *= alpha; o0 *= alpha; o1 *= alpha; o2 *= alpha; o3 *= alpha;
                }
                l_run += rs; m_run = mnew;
            }
            const bf16x8 p00 = pack8(s0, 0), p01 = pack8(s0, 1), p10 = pack8(s1, 0), p11 = pack8(s1, 1);
#define AT_PV(o, vf) do { o = MFMA32(vf[0], p00, o); o = MFMA32(vf[1], p01, o); o = MFMA32(vf[2], p10, o); o = MFMA32(vf[3], p11, o); } while (0)
            __builtin_amdgcn_sched_barrier(0); __builtin_amdgcn_s_setprio(1);
            AT_RV(vf1, 1); AT_PV(o0, vf0); __builtin_amdgcn_sched_barrier(0);
            AT_RV(vf2, 2); AT_PV(o1, vf1); __builtin_amdgcn_sched_barrier(0);
            AT_RV(vf3, 3); AT_PV(o2, vf2); __builtin_amdgcn_sched_barrier(0);
            AT_PV(o3, vf3); __builtin_amdgcn_s_setprio(0); __builtin_amdgcn_sched_barrier(0);
#undef AT_PV
#undef AT_RV
        }
        if (TYPE == 2) { wv_done = wv_done || ((kt <= wlast) && __all(carry < -140.f)); if (lane == 0) *(LAS int*)(lds + FLAGS + (it & 1) * 32 + wid * 4) = wv_done ? 1 : 0; }
        so = (so == 2 * SLOT) ? 0u : so + SLOT; so2 = (so2 == 2 * SLOT) ? 0u : so2 + SLOT;
        have_s = false;
        if (ahead && it + 1 < NT && AT_TILE(it + 1) <= wlast) { AT_QK(so); have_s = true; }
    }
#undef AT_ISSUE
#undef AT_TILE
#undef AT_QK
#undef AT_RK
#undef AT_MK
#undef AT_KADDR
    float inv = 1.f;
    if (TYPE != 2) inv = 1.f / swap_sum(l_run);
    at_waitv<0>(); AT_BAR();
    {
        const unsigned ob = (unsigned)(wid * 8704 + l32 * 272 + 8 * hh);
#define AT_OUT(o, mb) do { _Pragma("unroll") for (int g = 0; g < 4; ++g) { u32x2 w; w.x = pk2(o[4 * g] * inv, o[4 * g + 1] * inv); w.y = pk2(o[4 * g + 2] * inv, o[4 * g + 3] * inv); \
            *(LAS u32x2*)(lds + ob + (mb) * 64 + g * 16) = w; } } while (0)
        AT_OUT(o0, 0); AT_OUT(o1, 1); AT_OUT(o2, 2); AT_OUT(o3, 3);
#undef AT_OUT
        const size_t tok0 = (size_t)b * 2048 + qt * 256 + wid * 32;
        const bf16_t* sg = (const bf16_t*)(ws + WS_SG) + (size_t)TYPE * T * 1024 + tok0 * 1024 + h * 128;
        bf16_t* ys = (bf16_t*)(ws + WS_YS) + (size_t)TYPE * T * 1024 + tok0 * 1024 + h * 128;
        u32x4 gv[8];
#pragma unroll
        for (int i = 0; i < 8; ++i) { const int c = lane + 64 * i, r = c >> 4, cc = c & 15; gv[i] = *(const u32x4*)(sg + (size_t)r * 1024 + cc * 8); }
#pragma unroll
        for (int i = 0; i < 8; ++i) { const int c = lane + 64 * i, r = c >> 4, cc = c & 15;
            const u32x4 ov = *(const LAS u32x4*)(lds + wid * 8704 + r * 272 + cc * 16); u32x4 w;
            w.x = pk2(__uint_as_float(ov.x << 16) * __uint_as_float(gv[i].x << 16), __uint_as_float(ov.x & 0xffff0000u) * __uint_as_float(gv[i].x & 0xffff0000u));
            w.y = pk2(__uint_as_float(ov.y << 16) * __uint_as_float(gv[i].y << 16), __uint_as_float(ov.y & 0xffff0000u) * __uint_as_float(gv[i].y & 0xffff0000u));
            w.z = pk2(__uint_as_float(ov.z << 16) * __uint_as_float(gv[i].z << 16), __uint_as_float(ov.z & 0xffff0000u) * __uint_as_float(gv[i].z & 0xffff0000u));
            w.w = pk2(__uint_as_float(ov.w << 16) * __uint_as_float(gv[i].w << 16), __uint_as_float(ov.w & 0xffff0000u) * __uint_as_float(gv[i].w & 0xffff0000u));
            *(u32x4*)(ys + (size_t)r * 1024 + cc * 8) = w; }
    }
}

__device__ __forceinline__ void attn_run(const Params& P, int type, int bh, int qt, LAS unsigned char* lds) {
    const int b = bh >> 3, h = bh & 7;
#ifndef ATT_MASK
#define ATT_MASK 7
#endif
    if ((ATT_MASK & 1) && type == 0) attn_item<0>(P, b, h, qt, lds); else if ((ATT_MASK & 2) && type == 1) attn_item<1>(P, b, h, qt, lds); else if ((ATT_MASK & 4) && type == 2) attn_item<2>(P, b, h, qt, lds);
}
__device__ __forceinline__ void phase_attn(const Params& P, LAS unsigned char* lds) {
    const int G = my_G(), c = my_bx();
    if (G == 256) {
        const int x = c & 7, j = c >> 3, bh = 4 * x + (j >> 3), k = j & 7;
        const int kf = (k == 7) ? 1 : (k == 6) ? 0 : 7 - k;
#pragma unroll 1
        for (int r = 0; r < 3; ++r) attn_run(P, r, bh, r == 0 ? k : r == 1 ? kf : 7 - k, lds);
    } else {
#pragma unroll 1
        for (int idx = c; idx < 768; idx += G) { const int qt = 7 - idx / 96, r = idx % 96; attn_run(P, r >> 5, r & 31, qt, lds); }
    }
    asm volatile("s_waitcnt vmcnt(0)" ::: "memory"); __syncthreads();
}

#define XB_TMO      128
#define XB_XCNT(j)  (256  + 64 * (j))
#define XB_XSUB(j)  (1280 + 64 * (j))
#define XB_XGEN(j)  (2304 + 64 * (j))
#define XB_TOP      3328
#define XB_TOPGEN   3392
#define XCD_BAR_WORDS 3456
#define XB_SPIN_CAP (1u << 18)
__device__ __forceinline__ unsigned xb_ld(unsigned* p)              { return __hip_atomic_load(p, __ATOMIC_RELAXED, __HIP_MEMORY_SCOPE_AGENT); }
__device__ __forceinline__ unsigned xb_add(unsigned* p, unsigned v) { return __hip_atomic_fetch_add(p, v, __ATOMIC_RELAXED, __HIP_MEMORY_SCOPE_AGENT); }
__device__ __forceinline__ unsigned xb_xcc_id() { return (unsigned)__builtin_amdgcn_s_getreg((3 << 11) | 20) & 0xFu; }
#define XB_SPIN(cond, bar) do { unsigned _sp = 0; while (cond) { __builtin_amdgcn_s_sleep(1); \
    if ((++_sp & 255u) == 0u) { if (xb_ld(&(bar)[XB_TMO])) break; if (_sp > XB_SPIN_CAP) { atomicAdd(&(bar)[XB_TMO], 1u); break; } } } } while (0)
struct XcdBarrier { unsigned* bar; unsigned x; volatile LAS unsigned* st; };
__device__ __forceinline__ XcdBarrier xcd_barrier_post(unsigned* bar, volatile LAS unsigned* st) {
    XcdBarrier b; b.bar = bar; b.x = xb_xcc_id(); b.st = st;
    if (threadIdx.x == 0) (void)xb_add(&bar[XB_XCNT(b.x)], 1u);
    return b;
}
__device__ __forceinline__ void xcd_barrier_complete(unsigned* bar, unsigned x, unsigned& nloc, unsigned& nx) {
    const unsigned G = gridDim.x * gridDim.y * gridDim.z;
    unsigned sum, cnt, mine, sp = 0u;
    for (;;) {
        sum = 0u; cnt = 0u; mine = 0u;
#pragma unroll
        for (unsigned j = 0; j < 16; ++j) { const unsigned c = xb_ld(&bar[XB_XCNT(j)]); sum += c; cnt += (c > 0u) ? 1u : 0u; mine = (j == x) ? c : mine; }
        if (sum == G) break;
        __builtin_amdgcn_s_sleep(1);
        if ((++sp & 255u) == 0u) { if (xb_ld(&bar[XB_TMO])) break; if (sp > XB_SPIN_CAP) { atomicAdd(&bar[XB_TMO], 1u); break; } }
    }
    nloc = mine > 0u ? mine : 1u; nx = cnt > 0u ? cnt : 1u;
}
__device__ __forceinline__ void xcd_barrier(const XcdBarrier& b) {
    asm volatile("s_waitcnt vmcnt(0)" ::: "memory");
    __syncthreads();
    if (threadIdx.x == 0) {
        unsigned* bar = b.bar;
        __builtin_amdgcn_s_waitcnt(0);
        unsigned nloc = b.st[0], nx = b.st[1];
        if (nloc == 0u) { xcd_barrier_complete(bar, b.x, nloc, nx); b.st[0] = nloc; b.st[1] = nx; }
        const unsigned old = xb_add(&bar[XB_XSUB(b.x)], 1u);
        const unsigned gen = old / nloc;
        if (old + 1u == (gen + 1u) * nloc) {
            __builtin_amdgcn_fence(__ATOMIC_RELEASE, "agent");
            asm volatile("s_waitcnt vmcnt(0)" ::: "memory");
            const unsigned og = xb_add(&bar[XB_TOP], 1u);
            const unsigned tg = og / nx;
            if (og + 1u == (tg + 1u) * nx) xb_add(&bar[XB_TOPGEN], 1u);
            else XB_SPIN(xb_ld(&bar[XB_TOPGEN]) == tg, bar);
            __builtin_amdgcn_fence(__ATOMIC_ACQUIRE, "agent");
            xb_add(&bar[XB_XGEN(b.x)], 1u);
            asm volatile("s_waitcnt vmcnt(0)" ::: "memory");
        } else {
            XB_SPIN(xb_ld(&bar[XB_XGEN(b.x)]) == gen, bar);
            __builtin_amdgcn_fence(__ATOMIC_ACQUIRE, "agent");
            asm volatile("s_waitcnt vmcnt(0)" ::: "memory");
        }
    }
    __syncthreads();
}

constexpr int N_PHASES = 2 + 6 * NLAYER;
__global__ void __launch_bounds__(512, 2) mega(Params P0) {
    extern __shared__ __attribute__((aligned(16))) unsigned char smem[];
    LAS unsigned char* lds = (LAS unsigned char*)smem;
    cg::grid_group grid = cg::this_grid();
    const int lo = P0.ph_lo, hi = P0.ph_hi;
    volatile LAS unsigned* xst = (volatile LAS unsigned*)(lds + 131072 + 16);
    if (threadIdx.x == 0) { xst[0] = 0u; xst[1] = 0u; }
    __syncthreads();
    const XcdBarrier xbar = xcd_barrier_post((unsigned*)(P0.ws + WS_BAR), xst);
#ifndef PH_MASK
#define PH_MASK 0xff
#endif
#ifndef DUP_MASK
#define DUP_MASK 0
#endif
#ifndef EXTRA_SYNC
#define EXTRA_SYNC 0
#endif
#define NDUP(bit) ((DUP_MASK & (bit)) ? 2 : 1)
#define IN(k) (lo <= (k) && (k) < hi)
#define SEAM(k) do { if (IN(k) && IN((k) + 1)) { if ((k) == 0) grid.sync(); else xcd_barrier(xbar); if (EXTRA_SYNC) xcd_barrier(xbar); } } while (0)
#define FRESH() Params P = P0; { unsigned char* w_ = P0.ws; asm volatile("" : "+s"(w_)); P.ws = w_; } unsigned char* ws = P.ws; (void)ws; const int G = my_G(), bx = my_bx(); (void)G; (void)bx
    if ((PH_MASK & 1) && IN(0)) { for (int d = 0; d < NDUP(1); ++d) { FRESH(); phase_prologue(P, lds, d); if (d + 1 < NDUP(1)) grid.sync(); } SEAM(0); }
#pragma unroll 1
    for (int l = 0; l < NLAYER; ++l) {
        const int p0 = 1 + 6 * l;
        if ((PH_MASK & 2) && IN(p0)) { FRESH(); phase_ln(P, l); SEAM(p0); }
        if ((PH_MASK & 4) && IN(p0 + 1)) {
            FRESH(); unsigned char* wl = ws + WS_W + (size_t)l * SZ_WL;
            __syncthreads();
            pg8::Gemm g{(const bf16_t*)(ws + WS_U), (const bf16_t*)wl, T, N1, DM}; pg8::StaticOrder S; S.init(T, N1, G, bx);
            Epi1 E{ws};
            for (int d = 0; d < NDUP(4); ++d) { pg8::gemm_phase<Epi1, pg8::StaticOrder, true, true>(lds, g, S, E); if (d + 1 < NDUP(4)) grid.sync(); }
            SEAM(p0 + 1);
        }
        if ((PH_MASK & 8) && IN(p0 + 2)) {
            { FRESH(); phase_small(P, l); }
            __syncthreads();
            { FRESH(); unsigned char* wl = ws + WS_W + (size_t)l * SZ_WL;
              pg8::Gemm g{(const bf16_t*)(ws + WS_CQ), (const bf16_t*)(wl + OFF_BT2Q), T, 1536, 512}; pg8::StaticOrder S; S.init(T, 1536, G, bx);
              Epi2<0> E{ws}; pg8::gemm_phase<Epi2<0>, pg8::StaticOrder, false, true>(lds, g, S, E); }
            __syncthreads();
            { FRESH(); unsigned char* wl = ws + WS_W + (size_t)l * SZ_WL;
              pg8::Gemm g{(const bf16_t*)(ws + WS_CKV), (const bf16_t*)(wl + OFF_BT2KV), T, 2048, 256}; pg8::StaticOrder S; S.init(T, 2048, G, bx);
              Epi2<1> E{ws}; pg8::gemm_phase<Epi2<1>, pg8::StaticOrder, false, true>(lds, g, S, E); }
            SEAM(p0 + 2);
        }
        if ((PH_MASK & 16) && IN(p0 + 3)) { for (int d = 0; d < NDUP(16); ++d) { FRESH(); phase_attn(P, lds); if (d + 1 < NDUP(16)) grid.sync(); } SEAM(p0 + 3); }
        if ((PH_MASK & 32) && IN(p0 + 4)) {
            FRESH(); unsigned char* wl = ws + WS_W + (size_t)l * SZ_WL;
            __syncthreads();
            pg8::Gemm g{(const bf16_t*)(ws + WS_YS), (const bf16_t*)(wl + OFF_BT3), 3 * T, 3 * 2048, 1024}; pg8::BranchOrder S; S.so.init(T, 2048, G, bx);
            Epi3 E{ws};
            pg8::gemm_phase<Epi3, pg8::BranchOrder, true, true>(lds, g, S, E);
            SEAM(p0 + 4);
        }
        if ((PH_MASK & 64) && IN(p0 + 5)) {
            FRESH(); unsigned char* wl = ws + WS_W + (size_t)l * SZ_WL;
            __syncthreads();
            pg8::Gemm g{(const bf16_t*)(ws + WS_MRG), (const bf16_t*)(wl + OFF_BT4), T, 2048, 2048}; pg8::StaticOrder S; S.init(T, 2048, G, bx);
            Epi4 E{(bf16_t*)(ws + WS_MRG2)};
            pg8::gemm_phase<Epi4, pg8::StaticOrder, false, true>(lds, g, S, E);
            SEAM(p0 + 5);
        }
    }
    if ((PH_MASK & 2) && IN(N_PHASES - 1)) { FRESH(); phase_ln(P, 4); }
#undef IN
#undef SEAM
#undef FRESH
}

extern "C" void kernel_launch(void* const* d_in, const int* in_sizes, int n_in, void* d_out, int out_size, void* d_ws, size_t ws_size, hipStream_t stream) {
    static int grid = 0;
    if (grid == 0) {
        if (n_in != 15 || ws_size < WS_END) { fprintf(stderr, "kernel_launch: bad inputs (n_in %d, ws %zu < %zu)\n", n_in, ws_size, (size_t)WS_END); grid = -1; return; }
        int dev = 0, cus = 0, per_cu = 0;
        hipGetDevice(&dev); hipDeviceGetAttribute(&cus, hipDeviceAttributeMultiprocessorCount, dev);
        if (hipFuncSetAttribute((const void*)mega, hipFuncAttributeMaxDynamicSharedMemorySize, LDS_BYTES) != hipSuccess) { fprintf(stderr, "kernel_launch: hipFuncSetAttribute failed\n"); grid = -1; return; }
        if (hipOccupancyMaxActiveBlocksPerMultiprocessor(&per_cu, (const void*)mega, 512, LDS_BYTES) != hipSuccess || per_cu < 1) { fprintf(stderr, "kernel_launch: occupancy query says %d\n", per_cu); per_cu = 1; }
        (void)hipGetLastError();
        grid = cus * per_cu;
    }
    if (grid < 0) return;
    (void)hipMemsetAsync((char*)d_ws + WS_CTR, 0, WS_ZERO_BYTES, stream);
    Params p{};
    p.x = (const float*)d_in[0]; p.c = (const float*)d_in[1]; p.pos = (const int*)d_in[2]; p.w_ada = (const float*)d_in[3]; p.b_ada = (const float*)d_in[4]; p.w_in = (const float*)d_in[5];
    p.qng = (const float*)d_in[6]; p.kvng = (const float*)d_in[7]; p.w_uq = (const float*)d_in[8]; p.w_ukv = (const float*)d_in[9]; p.fox_bias = (const float*)d_in[10];
    p.w_branch = (const float*)d_in[11]; p.w_out = (const float*)d_in[12]; p.ln_g = (const float*)d_in[13]; p.ln_b = (const float*)d_in[14];
    p.out = (float*)d_out; p.ws = (unsigned char*)d_ws;
#if PER_PHASE_LAUNCH
    for (int ph = 0; ph < N_PHASES; ++ph) { p.ph_lo = ph; p.ph_hi = ph + 1; hipLaunchKernelGGL(mega, dim3(grid), dim3(512), LDS_BYTES, stream, p); }
#else
    p.ph_lo = 0; p.ph_hi = N_PHASES;
    void* args[] = {&p};
    hipError_t e = hipLaunchCooperativeKernel((const void*)mega, dim3(grid), dim3(512), args, LDS_BYTES, stream);
    if (e != hipSuccess) fprintf(stderr, "kernel_launch: cooperative launch failed: %s (grid %d)\n", hipGetErrorString(e), grid);
#endif
}
```
